# Optimizing an MI355X kernel written in HIP

```python
import functools
import jax, jax.numpy as jnp
from jax import lax
import numpy as np

D_MODEL = 1024
BATCH = 8
SEQ = 2048
DEPTH = 4
DEC_BATCH = 128
DEC_SEQ = 1
PAST_LEN = 8192
PAGE_SIZE = 128

N_HEADS = 16
N_KV_HEADS = 2
HEAD_DIM = 64
GROUP = N_HEADS // N_KV_HEADS
WINDOW = 128
ATTN_W = N_HEADS * HEAD_DIM
KV_W = N_KV_HEADS * HEAD_DIM
D_RNN = 1280
N_RNN_BLOCKS = 10
RNN_BLOCK = D_RNN // N_RNN_BLOCKS
CONV_W = 4
LRU_C = 8.0
N_EXPERTS = 32
TOP_K = 4
D_FF = 1024
SWIGLU_LIMIT = 7.0
SWIGLU_ALPHA = 1.702
MOE_BLOCK = 128
LN_EPS = 1e-5
DEEPNORM_ALPHA = (2 * DEPTH) ** 0.25
DEEPNORM_BETA = (8 * DEPTH) ** -0.25
PROJ_SPLITS = [ATTN_W, KV_W, KV_W, D_RNN, D_RNN, D_MODEL, D_MODEL]
PROJ_W = sum(PROJ_SPLITS)

kernel_name = "hybrid_swa_rglru_moe_deepnorm_step"


def layer_norm(x, g, b):
    xf = x.astype(jnp.float32)
    mu = jnp.mean(xf, axis=-1, keepdims=True)
    var = jnp.mean(jnp.square(xf - mu), axis=-1, keepdims=True)
    return ((xf - mu) * lax.rsqrt(var + LN_EPS) * g + b).astype(x.dtype)


def alibi_slopes():
    h = jnp.arange(1, N_HEADS + 1, dtype=jnp.float32)
    return (2.0 ** (-8.0 * h / N_HEADS)).reshape(N_KV_HEADS, GROUP)


def window_attention(q, k, v, q_pos, k_pos, sinks):
    scale = HEAD_DIM ** -0.5
    scores = jnp.einsum('bnqhgd,bnshd->bnhgqs', q, k,
                        preferred_element_type=jnp.float32) * scale
    dist = (q_pos[:, :, None] - k_pos[:, None, :])
    valid = (dist >= 0) & (dist < WINDOW) & (k_pos[:, None, :] >= 0)
    slopes = alibi_slopes()[None, None, :, :, None, None]
    logits = scores - slopes * dist.astype(jnp.float32)[None, :, None, None]
    logits = jnp.where(valid[None, :, None, None], logits, -jnp.inf)
    sink = sinks.astype(jnp.float32).reshape(N_KV_HEADS, GROUP)[None, None, :, :, None, None]
    m = jnp.maximum(jnp.max(logits, axis=-1, keepdims=True), sink)
    p = jnp.exp(logits - m)
    denom = jnp.sum(p, axis=-1, keepdims=True) + jnp.exp(sink - m)
    probs = (p / denom).astype(v.dtype)
    return jnp.einsum('bnhgqs,bnshd->bnqhgd', probs, v)


def prompt_attend(q, k, v, sinks, cache_len):
    B, S = q.shape[:2]
    nb = S // WINDOW
    qb = q.reshape(B, nb, WINDOW, N_KV_HEADS, GROUP, HEAD_DIM)

    def band(t):
        tb = t.reshape(B, nb, WINDOW, N_KV_HEADS, HEAD_DIM)
        prev = jnp.pad(tb[:, :-1], ((0, 0), (1, 0), (0, 0), (0, 0), (0, 0)))
        return jnp.concatenate([prev, tb], axis=2)

    pos = jnp.arange(S, dtype=jnp.int32).reshape(nb, WINDOW)
    kpos = jnp.concatenate([pos - WINDOW, pos], axis=1)
    o = window_attention(qb, band(k), band(v), pos, kpos, sinks)
    return o.reshape(B, S, ATTN_W), k[:, S - cache_len:], v[:, S - cache_len:]


def sample_attend(q, k, v, sinks, ck, cv):
    B, T = q.shape[:2]
    cw = ck.shape[1]
    keys = jnp.concatenate([ck.astype(k.dtype), k], axis=1)
    vals = jnp.concatenate([cv.astype(v.dtype), v], axis=1)
    qpos = PAST_LEN + jnp.arange(T, dtype=jnp.int32)
    kpos = PAST_LEN - cw + jnp.arange(cw + T, dtype=jnp.int32)
    o = window_attention(q.reshape(B, 1, T, N_KV_HEADS, GROUP, HEAD_DIM),
                         keys[:, None], vals[:, None], qpos[None], kpos[None], sinks)
    return o.reshape(B, T, ATTN_W), keys[:, -cw:], vals[:, -cw:]


def rglru_branch(xr, conv_buf, h0, conv_w, conv_b, wa, ba, wx, bx, lam):
    B, T, _ = xr.shape
    xp = jnp.concatenate([conv_buf.astype(xr.dtype), xr], axis=1)
    xc = conv_b + xp[:, 0:T] * conv_w[0]
    for j in range(1, CONV_W):
        xc = xc + xp[:, j:j + T] * conv_w[j]
    new_buf = xp[:, T:]
    xcb = xc.reshape(B, T, N_RNN_BLOCKS, RNN_BLOCK)
    r = jax.nn.sigmoid(jnp.einsum('btnc,ncd->btnd', xcb, wa).reshape(B, T, D_RNN) + ba)
    i = jax.nn.sigmoid(jnp.einsum('btnc,ncd->btnd', xcb, wx).reshape(B, T, D_RNN) + bx)
    log_a = (-LRU_C * jax.nn.softplus(-lam.astype(jnp.float32))) * r.astype(jnp.float32)
    a = jnp.exp(log_a)
    b = jnp.sqrt(-jnp.expm1(2.0 * log_a)) * (i * xc).astype(jnp.float32)

    def step(h, ab):
        a_t, b_t = ab
        h = a_t * h + b_t
        return h, h

    h_last, hs = lax.scan(step, h0.astype(jnp.float32), (a.swapaxes(0, 1), b.swapaxes(0, 1)))
    return hs.swapaxes(0, 1).astype(xr.dtype), new_buf, h_last


def temporal_block(x, p, attend, conv_buf, h0):
    B, T, _ = x.shape
    proj = x @ p['w_in']
    offs = list(np.cumsum(PROJ_SPLITS)[:-1])
    q, k, v, xr, yr, ga, gb = jnp.split(proj, offs, axis=-1)
    q = q.reshape(B, T, N_HEADS, HEAD_DIM)
    k = k.reshape(B, T, N_KV_HEADS, HEAD_DIM)
    v = v.reshape(B, T, N_KV_HEADS, HEAD_DIM)
    o_attn, nk, nv = attend(q, k, v, p['attn_sinks'])
    y_rnn, new_buf, h_last = rglru_branch(xr, conv_buf, h0, p['conv_w'], p['conv_b'],
                                          p['rg_wa'], p['rg_ba'], p['rg_wx'], p['rg_bx'],
                                          p['rg_lambda'])
    y_rnn = y_rnn * jax.nn.gelu(yr)
    merged = (jax.nn.sigmoid(ga) * (o_attn @ p['w_attn_out'])
              + jax.nn.sigmoid(gb) * (y_rnn @ p['w_rnn_out']))
    return merged @ p['w_out'], nk, nv, new_buf, h_last


def moe(x, w_router, b_router, w_up, b_up, w_down, b_down):
    B, T, D = x.shape
    xt = x.reshape(-1, D)
    n_tok = xt.shape[0]
    logits = (xt @ w_router + b_router).astype(jnp.float32)
    top_v, top_i = lax.top_k(logits, TOP_K)
    gate = jax.nn.softmax(top_v, axis=-1)
    n = n_tok * TOP_K
    flat_e = top_i.reshape(-1).astype(jnp.int32)
    flat_tok = jnp.arange(n, dtype=jnp.int32) // TOP_K
    flat_g = gate.reshape(-1)
    order = jnp.argsort(flat_e)
    se = flat_e[order]
    counts = jnp.zeros((N_EXPERTS,), jnp.int32).at[flat_e].add(1)
    padded = (counts + MOE_BLOCK - 1) // MOE_BLOCK * MOE_BLOCK
    pad_end = jnp.cumsum(padded)
    pad_start = pad_end - padded
    start = jnp.cumsum(counts) - counts
    dest = pad_start[se] + jnp.arange(n, dtype=jnp.int32) - start[se]
    nb = -(-(n + N_EXPERTS * (MOE_BLOCK - 1)) // MOE_BLOCK)
    rows = nb * MOE_BLOCK
    row_tok = jnp.full((rows,), n_tok, jnp.int32).at[dest].set(flat_tok[order])
    row_g = jnp.zeros((rows,), jnp.float32).at[dest].set(flat_g[order])
    block_e = jnp.minimum(
        jnp.searchsorted(pad_end, jnp.arange(nb, dtype=jnp.int32) * MOE_BLOCK, side='right'),
        N_EXPERTS - 1).astype(jnp.int32)
    x_pad = jnp.concatenate([xt, jnp.zeros((1, D), xt.dtype)], axis=0)
    xb = x_pad[row_tok].reshape(nb, MOE_BLOCK, D)

    def expert_block(args):
        xblk, e = args
        h = xblk @ w_up[e] + b_up[e]
        glu, lin = h[:, :D_FF], h[:, D_FF:]
        glu = jnp.minimum(glu, SWIGLU_LIMIT)
        lin = jnp.clip(lin, -SWIGLU_LIMIT, SWIGLU_LIMIT)
        act = glu * jax.nn.sigmoid(SWIGLU_ALPHA * glu) * (lin + 1.0)
        return act @ w_down[e] + b_down[e]

    yb = lax.map(expert_block, (xb, block_e)).reshape(rows, D)
    y = jnp.zeros((n_tok + 1, D), jnp.float32).at[row_tok].add(
        yb.astype(jnp.float32) * row_g[:, None])[:n_tok]
    return y.astype(x.dtype).reshape(B, T, D)


def setup_inputs(seed: int = 0) -> dict:
    key = jax.random.key(seed)
    ks = jax.random.split(key, 28)
    f32 = jnp.float32

    def nrm(k, shape, s):
        return jax.random.normal(k, shape, f32) * s

    cw = min(WINDOW, PAST_LEN)
    beta = DEEPNORM_BETA
    col_scale = jnp.concatenate([
        jnp.ones((ATTN_W + KV_W,), f32), jnp.full((KV_W,), beta, f32),
        jnp.ones((2 * D_RNN + 2 * D_MODEL,), f32)])
    u = jax.random.uniform(ks[14], (DEPTH, D_RNN), f32, 0.9, 0.999)
    s = u ** (1.0 / LRU_C)
    return {
        "x_prompt": nrm(ks[0], (BATCH, SEQ, D_MODEL), 1.0),
        "x_sample": nrm(ks[1], (DEC_BATCH, DEC_SEQ, D_MODEL), 1.0),
        "cache_k": nrm(ks[2], (DEPTH, DEC_BATCH, cw, N_KV_HEADS, HEAD_DIM), 1.0),
        "cache_v": nrm(ks[3], (DEPTH, DEC_BATCH, cw, N_KV_HEADS, HEAD_DIM), beta),
        "state_conv": nrm(ks[4], (DEPTH, DEC_BATCH, CONV_W - 1, D_RNN), 1.0),
        "state_h": nrm(ks[5], (DEPTH, DEC_BATCH, D_RNN), 0.5),
        "w_in": nrm(ks[6], (DEPTH, D_MODEL, PROJ_W), D_MODEL ** -0.5) * col_scale,
        "attn_sinks": nrm(ks[7], (DEPTH, N_HEADS), 0.5),
        "conv_w": nrm(ks[8], (DEPTH, CONV_W, D_RNN), CONV_W ** -0.5),
        "conv_b": nrm(ks[9], (DEPTH, D_RNN), 0.02),
        "rg_wa": nrm(ks[10], (DEPTH, N_RNN_BLOCKS, RNN_BLOCK, RNN_BLOCK), RNN_BLOCK ** -0.5),
        "rg_ba": nrm(ks[11], (DEPTH, D_RNN), 0.02),
        "rg_wx": nrm(ks[12], (DEPTH, N_RNN_BLOCKS, RNN_BLOCK, RNN_BLOCK), RNN_BLOCK ** -0.5),
        "rg_bx": nrm(ks[13], (DEPTH, D_RNN), 0.02),
        "rg_lambda": jnp.log(s) - jnp.log1p(-s),
        "w_attn_out": nrm(ks[15], (DEPTH, ATTN_W, D_MODEL), beta * ATTN_W ** -0.5),
        "w_rnn_out": nrm(ks[16], (DEPTH, D_RNN, D_MODEL), beta * D_RNN ** -0.5),
        "w_out": nrm(ks[17], (DEPTH, D_MODEL, D_MODEL), beta * D_MODEL ** -0.5),
        "ln1_g": 1.0 + nrm(ks[18], (DEPTH, D_MODEL), 0.02),
        "ln1_b": nrm(ks[19], (DEPTH, D_MODEL), 0.02),
        "w_router": nrm(ks[20], (DEPTH, D_MODEL, N_EXPERTS), D_MODEL ** -0.5),
        "b_router": nrm(ks[21], (DEPTH, N_EXPERTS), 0.01),
        "w_up": nrm(ks[22], (DEPTH, N_EXPERTS, D_MODEL, 2 * D_FF), beta * D_MODEL ** -0.5),
        "b_up": nrm(ks[23], (DEPTH, N_EXPERTS, 2 * D_FF), 0.02),
        "w_down": nrm(ks[24], (DEPTH, N_EXPERTS, D_FF, D_MODEL), beta * D_FF ** -0.5),
        "b_down": nrm(ks[25], (DEPTH, N_EXPERTS, D_MODEL), 0.02),
        "ln2_g": 1.0 + nrm(ks[26], (DEPTH, D_MODEL), 0.02),
        "ln2_b": nrm(ks[27], (DEPTH, D_MODEL), 0.02),
    }


def reference(x_prompt, x_sample, cache_k, cache_v, state_conv, state_h,
              w_in, attn_sinks, conv_w, conv_b, rg_wa, rg_ba, rg_wx, rg_bx, rg_lambda,
              w_attn_out, w_rnn_out, w_out, ln1_g, ln1_b,
              w_router, b_router, w_up, b_up, w_down, b_down, ln2_g, ln2_b):
    cw = cache_k.shape[2]
    xp, xs = x_prompt, x_sample
    Bp, Bs = xp.shape[0], xs.shape[0]
    nk_p, nv_p, nc_p, nh_p = [], [], [], []
    nk_s, nv_s, nc_s, nh_s = [], [], [], []
    for l in range(DEPTH):
        p = {
            'w_in': w_in[l], 'attn_sinks': attn_sinks[l], 'conv_w': conv_w[l], 'conv_b': conv_b[l],
            'rg_wa': rg_wa[l], 'rg_ba': rg_ba[l], 'rg_wx': rg_wx[l], 'rg_bx': rg_bx[l],
            'rg_lambda': rg_lambda[l], 'w_attn_out': w_attn_out[l], 'w_rnn_out': w_rnn_out[l],
            'w_out': w_out[l],
        }
        moe_l = functools.partial(moe, w_router=w_router[l], b_router=b_router[l], w_up=w_up[l],
                                  b_up=b_up[l], w_down=w_down[l], b_down=b_down[l])
        mix_p, k_p, v_p, c_p, h_p = temporal_block(
            xp, p, functools.partial(prompt_attend, cache_len=cw),
            jnp.zeros((Bp, CONV_W - 1, D_RNN), xp.dtype), jnp.zeros((Bp, D_RNN), jnp.float32))
        xp = layer_norm(DEEPNORM_ALPHA * xp + mix_p, ln1_g[l], ln1_b[l])
        xp = layer_norm(DEEPNORM_ALPHA * xp + moe_l(xp), ln2_g[l], ln2_b[l])
        mix_s, k_s, v_s, c_s, h_s = temporal_block(
            xs, p, functools.partial(sample_attend, ck=cache_k[l], cv=cache_v[l]),
            state_conv[l], state_h[l])
        xs = layer_norm(DEEPNORM_ALPHA * xs + mix_s, ln1_g[l], ln1_b[l])
        xs = layer_norm(DEEPNORM_ALPHA * xs + moe_l(xs), ln2_g[l], ln2_b[l])
        nk_p.append(k_p); nv_p.append(v_p); nc_p.append(c_p); nh_p.append(h_p)
        nk_s.append(k_s); nv_s.append(v_s); nc_s.append(c_s); nh_s.append(h_s)
    return (xp, xs,
            jnp.stack(nk_p), jnp.stack(nv_p), jnp.stack(nc_p), jnp.stack(nh_p),
            jnp.stack(nk_s), jnp.stack(nv_s), jnp.stack(nc_s), jnp.stack(nh_s))
```

```cpp
#include <hip/hip_runtime.h>
#include <cstdio>
#include <cstdint>

#ifndef MK_SINGLE
#define MK_SINGLE 0
#endif

#define GAS __attribute__((address_space(1)))
#define LAS __attribute__((address_space(3)))
typedef unsigned short bf16;
typedef short bf16x8 __attribute__((ext_vector_type(8)));
typedef short s16x4 __attribute__((ext_vector_type(4)));
typedef float f32x2 __attribute__((ext_vector_type(2)));
typedef float f32x4 __attribute__((ext_vector_type(4)));
typedef float f32x16 __attribute__((ext_vector_type(16)));
typedef unsigned u32x2 __attribute__((ext_vector_type(2)));
typedef unsigned u32x4 __attribute__((ext_vector_type(4)));

constexpr int D = 1024, BATCH = 8, SEQ = 2048, DEPTH = 4, DECB = 128, NH = 16, NKV = 2, HD = 64, WINDOW = 128;
constexpr int D_RNN = 1280, NRB = 10, RB = 128, NE = 32, TOPK = 4, DFF = 1024;
constexpr int PROJ_W = 5888, CQ = 0, CK = 1024, CV = 1152, CXR = 1280, CYR = 2560, CGA = 3840, CGB = 4864;
constexpr int TP = BATCH * SEQ, NTOK = TP + DECB, MPAD = 16640;
constexpr int CAP = 16640, CAPT = CAP / 256;
constexpr float LN_EPS = 1e-5f, ALPHA = 1.681792830507429f;
constexpr float LOG2E = 1.4426950408889634f;
constexpr float QSCALE = 0.125f * LOG2E;
constexpr size_t O_Y = 0, O_NKP = 16908288, O_NVP = 17432576, O_NCP = 17956864, O_NHP = 18079744, O_NKS = 18120704, O_NVS = 26509312, O_NCS = 34897920, O_NHS = 36864000;

constexpr size_t WS_CTL = 0, CTL_BYTES = 1u << 20;
constexpr size_t WS_WIN = CTL_BYTES;
constexpr size_t WS_WAO = WS_WIN + (size_t)DEPTH * PROJ_W * D * 2;
constexpr size_t WS_WRO = WS_WAO + (size_t)DEPTH * D * D * 2;
constexpr size_t WS_WO  = WS_WRO + (size_t)DEPTH * D * D_RNN * 2;
constexpr size_t WS_WUP = WS_WO + (size_t)DEPTH * D * D * 2;
constexpr size_t WS_WDN = WS_WUP + (size_t)DEPTH * NE * 2 * DFF * D * 2;
constexpr size_t WS_WGA = WS_WDN + (size_t)DEPTH * NE * D * DFF * 2;
constexpr size_t WS_WGX = WS_WGA + (size_t)DEPTH * NRB * RB * RB * 2;
constexpr size_t WS_X   = WS_WGX + (size_t)DEPTH * NRB * RB * RB * 2;
constexpr size_t WS_XB  = WS_X + (size_t)MPAD * D * 4;
constexpr size_t WS_PROJ = WS_XB + (size_t)MPAD * D * 2;
constexpr size_t WS_OATT = WS_PROJ + (size_t)MPAD * PROJ_W * 2;
constexpr size_t WS_YRNN = WS_OATT + (size_t)MPAD * D * 2;
constexpr size_t WS_TMP = WS_YRNN + (size_t)MPAD * D_RNN * 2;
constexpr size_t WS_MERG = WS_TMP + (size_t)MPAD * D * 4;
constexpr size_t WS_X1  = WS_MERG + (size_t)MPAD * D * 2;
constexpr size_t WS_X1B = WS_X1 + (size_t)MPAD * D * 4;
constexpr size_t WS_SLOT = WS_X1B + (size_t)MPAD * D * 2;
constexpr size_t WS_GATE = WS_SLOT + (size_t)MPAD * 4 * 4;
constexpr size_t WS_ROWTOK = WS_GATE + (size_t)MPAD * 4 * 4;
constexpr size_t WS_ACT = WS_ROWTOK + (size_t)NE * CAP * 4;
constexpr size_t WS_YK  = WS_ACT + (size_t)NE * CAP * DFF * 2;
constexpr size_t WS_END = WS_YK + (size_t)NE * CAP * D * 2;
constexpr int CW_BAR = 4096, CW_CNT = 8192;

constexpr int LDS_ROWS = 131072;
constexpr int LDS_CTL = 147456;
constexpr int LDS_BYTES = 148480;
constexpr int MAXR = 16;

__device__ __forceinline__ float bflo(unsigned u) { return __uint_as_float(u << 16); }
__device__ __forceinline__ float bfhi(unsigned u) { return __uint_as_float(u & 0xffff0000u); }
__device__ __forceinline__ float bf2f(bf16 b) { return __uint_as_float(((unsigned)b) << 16); }
__device__ __forceinline__ unsigned cvt_pk_bf16(float lo, float hi) { unsigned r; asm volatile("v_cvt_pk_bf16_f32 %0, %1, %2" : "=v"(r) : "v"(lo), "v"(hi)); return r; }
__device__ __forceinline__ float fast_sigmoid(float x) { return __builtin_amdgcn_rcpf(1.0f + __builtin_amdgcn_exp2f(-LOG2E * x)); }
__device__ __forceinline__ float gelu_tanh(float x) { const float u = x + 0.044715f * x * x * x; return x * __builtin_amdgcn_rcpf(1.0f + __builtin_amdgcn_exp2f(-2.0f * 0.7978845608028654f * LOG2E * u)); }
__device__ __forceinline__ float wave_sum(float v) {
#pragma unroll
    for (int o = 1; o < 64; o <<= 1) v += __shfl_xor(v, o);
    return v;
}
__device__ __forceinline__ float wave_max(float v) {
#pragma unroll
    for (int o = 1; o < 64; o <<= 1) v = fmaxf(v, __shfl_xor(v, o));
    return v;
}
#define LDS_WAIT() asm volatile("s_waitcnt lgkmcnt(0)" ::: "memory")
#define VM_WAIT() asm volatile("s_waitcnt vmcnt(0)" ::: "memory")

namespace pg8 {
constexpr int BM = 256, BK = 64, HALF = 128, HTB = HALF * BK * 2, STAGE_BYTES = 8 * HTB, NXCD = 8, WGM = 8;
__host__ __device__ __forceinline__ int lds_byte(int r, int c) { const int st = (r >> 4) * 2 + (c >> 5), rr = r & 15, cc = c & 31, ob = rr * 64 + cc * 2; return st * 1024 + (ob ^ (((ob >> 9) & 1) << 5)); }
__host__ __device__ __forceinline__ void stage_rc(int b, int& R, int& C) { const int st = b / 1024, sb = b % 1024, swz = sb ^ (((sb >> 9) & 1) << 5); R = (st >> 1) * 16 + swz / 64; C = (st & 1) * 32 + (swz % 64) / 2; }
__host__ __device__ __forceinline__ int perm32(int rho) { const int n = rho >> 4, i = rho & 15; return 8 * (i >> 2) + 4 * n + (i & 3); }

struct Unit { int pm, pn, e, nv; };
struct Gemm { const bf16* A; const bf16* Bt; int K; };

struct StaticOrder {
    int nM, nN, nwg, G, c;
    __device__ void init(int M, int N, int G_, int c_) { nM = M / BM; nN = N / BM; nwg = nM * nN; G = G_; c = c_; }
    __device__ bool next(int i, Unit& u) const {
        const long L = (long)i * G + c; if (L >= nwg) return false;
        int wgid = (int)L; { const int q = nwg / NXCD, r = nwg % NXCD, xcd = wgid % NXCD, off = wgid / NXCD; wgid = (xcd < r ? xcd * (q + 1) : r * (q + 1) + (xcd - r) * q) + off; }
        const int nig = WGM * nN, gid = wgid / nig, fm = gid * WGM, gsz = (nM - fm) < WGM ? (nM - fm) : WGM;
        u.pm = fm + ((wgid % nig) % gsz); u.pn = (wgid % nig) / gsz; u.e = 0; u.nv = BM; return true;
    }
};
struct MoeOrder {
    const LAS int* tbl;
    __device__ bool next(int i, Unit& u) const {
        if (i >= MAXR) return false;
        const int pm = __builtin_amdgcn_readfirstlane(tbl[i * 4 + 0]); if (pm < 0) return false;
        u.pm = pm; u.pn = __builtin_amdgcn_readfirstlane(tbl[i * 4 + 1]); u.e = __builtin_amdgcn_readfirstlane(tbl[i * 4 + 2]); u.nv = __builtin_amdgcn_readfirstlane(tbl[i * 4 + 3]); return true;
    }
};

template <class Epi, class Sched, bool GATHER>
__device__ __forceinline__ void gemm_phase(LAS unsigned char* lds, const Gemm g, const Sched& S, const Epi& E, const LAS int* rows_lds) {
    int tid = threadIdx.x; asm volatile("" : "+v"(tid));
    const int wid = __builtin_amdgcn_readfirstlane(tid >> 6), lane = tid & 63, wr = wid >> 2, wc = wid & 3, fr = lane & 15, fq = lane >> 4;
    const int K = g.K, nt = K / BK;
    int Rr[2], Cc[2]; unsigned voffB[2];
#pragma unroll
    for (int i = 0; i < 2; ++i) { int R, C; stage_rc(tid * 16 + i * 8192, R, C); Rr[i] = R; Cc[i] = C; const int Rb = (R & ~31) + perm32(R & 31); voffB[i] = (unsigned)(Rb * K + C) * 2u; }
    const size_t kstep = (size_t)(BK * 2);
    const size_t hstep = (size_t)HALF * K * 2;
    const size_t tstep = 2 * hstep;
    const unsigned ldsw = (unsigned)wid * 1024u;
    const int aoff = lds_byte(wr * 64 + fr, fq * 8), boff = lds_byte(wc * 32 + fr, fq * 8);
#define PG8_SA(b, h) (((b) * 2 + (h)) * HTB)
#define PG8_SB(b, h) ((4 + (b) * 2 + (h)) * HTB)
#define PG8_STAGE_B(bufoff, gbase) do { _Pragma("unroll") for (int _i = 0; _i < 2; ++_i) \
        __builtin_amdgcn_global_load_lds((const unsigned*)((const char*)(gbase) + voffB[_i]), (LAS unsigned*)(lds + (bufoff) + ldsw + _i * 8192), 16, 0, 0); } while (0)
#define PG8_STAGE_A(bufoff, gbase, o0, o1) do { \
        __builtin_amdgcn_global_load_lds((const unsigned*)((const char*)(gbase) + (o0)), (LAS unsigned*)(lds + (bufoff) + ldsw), 16, 0, 0); \
        __builtin_amdgcn_global_load_lds((const unsigned*)((const char*)(gbase) + (o1)), (LAS unsigned*)(lds + (bufoff) + ldsw + 8192), 16, 0, 0); } while (0)
#define PG8_SETA(v, u, slot) do { _Pragma("unroll") for (int h_ = 0; h_ < 2; ++h_) _Pragma("unroll") for (int i_ = 0; i_ < 2; ++i_) { \
        if constexpr (GATHER) { const int tok_ = rows_lds[(slot) * 256 + h_ * HALF + Rr[i_]]; (v)[h_][i_] = (unsigned)(tok_ * K + Cc[i_]) * 2u; } \
        else (v)[h_][i_] = (unsigned)((h_ * HALF + Rr[i_]) * K + Cc[i_]) * 2u; } } while (0)
#define PG8_LDA(dst, b, h) do { _Pragma("unroll") for (int m = 0; m < 4; ++m) _Pragma("unroll") for (int k = 0; k < 2; ++k) dst[m][k] = *(const LAS bf16x8*)(lds + PG8_SA(b, h) + aoff + m * 2048 + k * 1024); } while (0)
#define PG8_LDB(dst, b, h) do { _Pragma("unroll") for (int n = 0; n < 2; ++n) _Pragma("unroll") for (int k = 0; k < 2; ++k) dst[n][k] = *(const LAS bf16x8*)(lds + PG8_SB(b, h) + boff + n * 2048 + k * 1024); } while (0)
#define PG8_MMA(ai, bj, At, Bt) do { __builtin_amdgcn_s_setprio(1); _Pragma("unroll") for (int m = 0; m < 4; ++m) _Pragma("unroll") for (int n = 0; n < 2; ++n) _Pragma("unroll") for (int k = 0; k < 2; ++k) \
        acc[ai][bj][m][n] = __builtin_amdgcn_mfma_f32_16x16x32_bf16(Bt[n][k], At[m][k], acc[ai][bj][m][n], 0, 0, 0); __builtin_amdgcn_s_setprio(0); } while (0)
#define PG8_WAIT_V(n) asm volatile("s_waitcnt vmcnt(" #n ")" ::: "memory")
#define PG8_WAIT_L(n) asm volatile("s_waitcnt lgkmcnt(" #n ")" ::: "memory")
#define PG8_BAR __builtin_amdgcn_s_barrier()
#define PG8_SCHED __builtin_amdgcn_sched_barrier(0)
    Unit cur, nxt; int ui = 0;
    if (!S.next(0, cur)) return;
    f32x4 acc[2][2][4][2];
#pragma unroll
    for (int a = 0; a < 2; ++a)
#pragma unroll
        for (int b = 0; b < 2; ++b)
#pragma unroll
            for (int m = 0; m < 4; ++m)
#pragma unroll
                for (int n = 0; n < 2; ++n) acc[a][b][m][n] = (f32x4){0.f, 0.f, 0.f, 0.f};
    bf16x8 At[4][2], B0[2][2], B1[2][2];
    unsigned vAc[2][2], vAn[2][2];
    PG8_SETA(vAc, cur, 0);
    const char* cA = (const char*)g.A + (GATHER ? (size_t)0 : (size_t)cur.pm * tstep); const char* cB = (const char*)g.Bt + (size_t)cur.pn * tstep;
    PG8_STAGE_B(PG8_SB(0, 0), cB); PG8_STAGE_B(PG8_SB(0, 1), cB + hstep); PG8_STAGE_A(PG8_SA(0, 0), cA, vAc[0][0], vAc[0][1]); PG8_STAGE_A(PG8_SA(0, 1), cA, vAc[1][0], vAc[1][1]);
    if (wr == 1) PG8_BAR;
    PG8_WAIT_V(2); PG8_BAR;
    PG8_STAGE_B(PG8_SB(1, 0), cB + kstep); PG8_STAGE_A(PG8_SA(1, 0), cA + kstep, vAc[0][0], vAc[0][1]); PG8_STAGE_B(PG8_SB(1, 1), cB + hstep + kstep);
    PG8_WAIT_V(6); PG8_BAR;
    for (;;) {
        const bool has_next = S.next(ui + 1, nxt);
        const char* nA; const char* nB;
        if (has_next) { nA = (const char*)g.A + (GATHER ? (size_t)0 : (size_t)nxt.pm * tstep); nB = (const char*)g.Bt + (size_t)nxt.pn * tstep; if constexpr (GATHER) PG8_SETA(vAn, nxt, ui + 1); }
        else { nA = cA; nB = cB;
            if constexpr (GATHER) {
#pragma unroll
            for (int h_ = 0; h_ < 2; ++h_)
#pragma unroll
                for (int i_ = 0; i_ < 2; ++i_) vAn[h_][i_] = vAc[h_][i_]; } }
        for (int t = 0; t < nt; t += 2) {
            const bool last = (t == nt - 2);
            const char* a1 = cA + (size_t)(t + 1) * kstep;
            const char* a2 = last ? nA : cA + (size_t)(t + 2) * kstep; const char* b2 = last ? nB : cB + (size_t)(t + 2) * kstep;
            const char* a3 = a2 + kstep; const char* b3 = b2 + kstep;
            unsigned o00 = vAc[0][0], o01 = vAc[0][1], o10 = vAc[1][0], o11 = vAc[1][1];
            if constexpr (GATHER) { if (last) { o00 = vAn[0][0]; o01 = vAn[0][1]; o10 = vAn[1][0]; o11 = vAn[1][1]; } }
            PG8_LDB(B0, 0, 0); PG8_LDB(B1, 0, 1); PG8_SCHED; PG8_LDA(At, 0, 0); PG8_STAGE_A(PG8_SA(1, 1), a1, vAc[1][0], vAc[1][1]);
            PG8_WAIT_V(8); PG8_WAIT_L(0); PG8_BAR; PG8_MMA(0, 0, At, B0); PG8_MMA(0, 1, At, B1); PG8_BAR; PG8_SCHED;
            PG8_LDA(At, 0, 1); PG8_STAGE_B(PG8_SB(0, 0), b2); PG8_STAGE_B(PG8_SB(0, 1), b2 + hstep); PG8_STAGE_A(PG8_SA(0, 0), a2, o00, o01);
            PG8_WAIT_V(8); PG8_WAIT_L(0); PG8_BAR; PG8_MMA(1, 0, At, B0); PG8_MMA(1, 1, At, B1); PG8_BAR; PG8_SCHED;
            PG8_LDB(B0, 1, 0); PG8_LDB(B1, 1, 1); PG8_SCHED; PG8_LDA(At, 1, 0); PG8_STAGE_A(PG8_SA(0, 1), a2, o10, o11);
            PG8_WAIT_V(8); PG8_WAIT_L(0); PG8_BAR; PG8_MMA(0, 0, At, B0); PG8_MMA(0, 1, At, B1); PG8_BAR; PG8_SCHED;
            PG8_LDA(At, 1, 1); PG8_STAGE_B(PG8_SB(1, 0), b3); PG8_STAGE_B(PG8_SB(1, 1), b3 + hstep); PG8_STAGE_A(PG8_SA(1, 0), a3, o00, o01);
            PG8_WAIT_V(8); PG8_WAIT_L(0); PG8_BAR; PG8_MMA(1, 0, At, B0); PG8_MMA(1, 1, At, B1); PG8_BAR; PG8_SCHED;
        }
        if (wr == 0) PG8_BAR;
        E(acc, cur, wr, wc, fr, fq);
        if (!has_next) break;
#pragma unroll
        for (int a = 0; a < 2; ++a)
#pragma unroll
            for (int b = 0; b < 2; ++b)
#pragma unroll
                for (int m = 0; m < 4; ++m)
#pragma unroll
                    for (int n = 0; n < 2; ++n) acc[a][b][m][n] = (f32x4){0.f, 0.f, 0.f, 0.f};
        cur = nxt; cA = nA; cB = nB; ++ui;
        if constexpr (GATHER) {
#pragma unroll
        for (int h_ = 0; h_ < 2; ++h_)
#pragma unroll
            for (int i_ = 0; i_ < 2; ++i_) vAc[h_][i_] = vAn[h_][i_]; }
        if (wr == 1) PG8_BAR;
    }
    PG8_WAIT_V(0);
    PG8_BAR;
#undef PG8_SA
#undef PG8_SB
#undef PG8_STAGE_A
#undef PG8_STAGE_B
#undef PG8_SETA
#undef PG8_LDA
#undef PG8_LDB
#undef PG8_MMA
#undef PG8_WAIT_V
#undef PG8_WAIT_L
#undef PG8_BAR
#undef PG8_SCHED
}
}

typedef f32x4 AccT[2][2][4][2];
struct EpiIn {
    bf16* O;
    template <int MODE> __device__ __forceinline__ void run(const AccT& acc, const pg8::Unit& u, int wr, int wc, int fr, int fq) const {
        const int row0 = u.pm * 256 + wr * 64 + fr, col0 = u.pn * 256 + wc * 32 + 8 * fq;
#pragma unroll
        for (int ai = 0; ai < 2; ++ai)
#pragma unroll
            for (int m = 0; m < 4; ++m) { bf16* rowp = O + (size_t)(row0 + ai * 128 + m * 16) * PROJ_W + col0;
#pragma unroll
                for (int bj = 0; bj < 2; ++bj) { f32x4 v0 = acc[ai][bj][m][0], v1 = acc[ai][bj][m][1];
                    if (MODE == 1) { v0 = v0 * QSCALE; v1 = v1 * QSCALE; }
                    if (MODE == 2) {
#pragma unroll
                        for (int j = 0; j < 4; ++j) { v0[j] = gelu_tanh(v0[j]); v1[j] = gelu_tanh(v1[j]); } }
                    if (MODE == 3) {
#pragma unroll
                        for (int j = 0; j < 4; ++j) { v0[j] = fast_sigmoid(v0[j]); v1[j] = fast_sigmoid(v1[j]); } }
                    u32x4 w; w.x = cvt_pk_bf16(v0[0], v0[1]); w.y = cvt_pk_bf16(v0[2], v0[3]); w.z = cvt_pk_bf16(v1[0], v1[1]); w.w = cvt_pk_bf16(v1[2], v1[3]);
                    *(u32x4*)(rowp + bj * 128) = w; } }
    }
    __device__ __forceinline__ void operator()(const AccT& acc, const pg8::Unit& u, int wr, int wc, int fr, int fq) const {
        const int pn = u.pn;
        if (pn < 4) run<1>(acc, u, wr, wc, fr, fq); else if (pn < 10) run<0>(acc, u, wr, wc, fr, fq); else if (pn < 15) run<2>(acc, u, wr, wc, fr, fq); else run<3>(acc, u, wr, wc, fr, fq);
    }
};
struct EpiAo {
    float* T; const bf16* P;
    __device__ __forceinline__ void operator()(const AccT& acc, const pg8::Unit& u, int wr, int wc, int fr, int fq) const {
        const int row0 = u.pm * 256 + wr * 64 + fr, col0 = u.pn * 256 + wc * 32 + 8 * fq;
#pragma unroll
        for (int ai = 0; ai < 2; ++ai)
#pragma unroll
            for (int m = 0; m < 4; ++m) { const size_t r = (size_t)(row0 + ai * 128 + m * 16);
#pragma unroll
                for (int bj = 0; bj < 2; ++bj) { const u32x4 gw = *(const u32x4*)(P + r * PROJ_W + CGA + col0 + bj * 128);
                    f32x4 v0 = acc[ai][bj][m][0], v1 = acc[ai][bj][m][1];
                    v0[0] *= bflo(gw.x); v0[1] *= bfhi(gw.x); v0[2] *= bflo(gw.y); v0[3] *= bfhi(gw.y); v1[0] *= bflo(gw.z); v1[1] *= bfhi(gw.z); v1[2] *= bflo(gw.w); v1[3] *= bfhi(gw.w);
                    float* tp = T + r * D + col0 + bj * 128; *(f32x4*)tp = v0; *(f32x4*)(tp + 4) = v1; }
                asm volatile("" ::: "memory"); }
    }
};
struct EpiRo {
    const float* T; const bf16* P; bf16* O;
    __device__ __forceinline__ void operator()(const AccT& acc, const pg8::Unit& u, int wr, int wc, int fr, int fq) const {
        const int row0 = u.pm * 256 + wr * 64 + fr, col0 = u.pn * 256 + wc * 32 + 8 * fq;
#pragma unroll
        for (int ai = 0; ai < 2; ++ai)
#pragma unroll
            for (int m = 0; m < 4; ++m) { const size_t r = (size_t)(row0 + ai * 128 + m * 16);
#pragma unroll
                for (int bj = 0; bj < 2; ++bj) { const u32x4 gw = *(const u32x4*)(P + r * PROJ_W + CGB + col0 + bj * 128);
                    const float* tp = T + r * D + col0 + bj * 128; const f32x4 t0 = *(const f32x4*)tp, t1 = *(const f32x4*)(tp + 4);
                    f32x4 v0 = acc[ai][bj][m][0], v1 = acc[ai][bj][m][1];
                    v0[0] = t0[0] + v0[0] * bflo(gw.x); v0[1] = t0[1] + v0[1] * bfhi(gw.x); v0[2] = t0[2] + v0[2] * bflo(gw.y); v0[3] = t0[3] + v0[3] * bfhi(gw.y);
                    v1[0] = t1[0] + v1[0] * bflo(gw.z); v1[1] = t1[1] + v1[1] * bfhi(gw.z); v1[2] = t1[2] + v1[2] * bflo(gw.w); v1[3] = t1[3] + v1[3] * bfhi(gw.w);
                    u32x4 w; w.x = cvt_pk_bf16(v0[0], v0[1]); w.y = cvt_pk_bf16(v0[2], v0[3]); w.z = cvt_pk_bf16(v1[0], v1[1]); w.w = cvt_pk_bf16(v1[2], v1[3]);
                    *(u32x4*)(O + r * D + col0 + bj * 128) = w; }
                asm volatile("" ::: "memory"); }
    }
};
struct EpiF32 {
    float* T;
    __device__ __forceinline__ void operator()(const AccT& acc, const pg8::Unit& u, int wr, int wc, int fr, int fq) const {
        const int row0 = u.pm * 256 + wr * 64 + fr, col0 = u.pn * 256 + wc * 32 + 8 * fq;
#pragma unroll
        for (int ai = 0; ai < 2; ++ai)
#pragma unroll
            for (int m = 0; m < 4; ++m) { const size_t r = (size_t)(row0 + ai * 128 + m * 16);
#pragma unroll
                for (int bj = 0; bj < 2; ++bj) { float* tp = T + r * D + col0 + bj * 128; *(f32x4*)tp = acc[ai][bj][m][0]; *(f32x4*)(tp + 4) = acc[ai][bj][m][1]; } }
    }
};
struct EpiUp {
    bf16* ACT; const float* bup;
    __device__ __forceinline__ void operator()(const AccT& acc, const pg8::Unit& u, int wr, int wc, int fr, int fq) const {
        const int pnl = u.pn - u.e * 8;
        const int row0 = u.pm * 256 + wr * 64 + fr, a0 = pnl * 128 + wc * 16 + 4 * fq;
        const float* bb = bup + (size_t)u.e * (2 * DFF);
        f32x4 bg[2], bl[2];
#pragma unroll
        for (int bj = 0; bj < 2; ++bj) { bg[bj] = *(const f32x4*)(bb + a0 + bj * 64); bl[bj] = *(const f32x4*)(bb + DFF + a0 + bj * 64); }
#pragma unroll
        for (int ai = 0; ai < 2; ++ai)
#pragma unroll
            for (int m = 0; m < 4; ++m) { bf16* rowp = ACT + (size_t)(row0 + ai * 128 + m * 16) * DFF + a0;
#pragma unroll
                for (int bj = 0; bj < 2; ++bj) { f32x4 gl = acc[ai][bj][m][0] + bg[bj], ln = acc[ai][bj][m][1] + bl[bj]; float o[4];
#pragma unroll
                    for (int j = 0; j < 4; ++j) { const float gq = fminf(gl[j], 7.0f), lq = fminf(fmaxf(ln[j], -7.0f), 7.0f); o[j] = gq * fast_sigmoid(1.702f * gq) * (lq + 1.0f); }
                    u32x2 w; w.x = cvt_pk_bf16(o[0], o[1]); w.y = cvt_pk_bf16(o[2], o[3]); *(u32x2*)(rowp + bj * 64) = w; } }
    }
};
struct EpiDn {
    bf16* YK; const float* bdn;
    __device__ __forceinline__ void operator()(const AccT& acc, const pg8::Unit& u, int wr, int wc, int fr, int fq) const {
        const int pnl = u.pn - u.e * 4;
        const int row0 = u.pm * 256 + wr * 64 + fr, col0 = pnl * 256 + wc * 32 + 8 * fq;
        const float* bb = bdn + (size_t)u.e * D + col0;
        f32x4 bv[2][2];
#pragma unroll
        for (int bj = 0; bj < 2; ++bj) { bv[bj][0] = *(const f32x4*)(bb + bj * 128); bv[bj][1] = *(const f32x4*)(bb + bj * 128 + 4); }
#pragma unroll
        for (int ai = 0; ai < 2; ++ai)
#pragma unroll
            for (int m = 0; m < 4; ++m) { bf16* rowp = YK + (size_t)(row0 + ai * 128 + m * 16) * D + col0;
#pragma unroll
                for (int bj = 0; bj < 2; ++bj) { const f32x4 v0 = acc[ai][bj][m][0] + bv[bj][0], v1 = acc[ai][bj][m][1] + bv[bj][1];
                    u32x4 w; w.x = cvt_pk_bf16(v0[0], v0[1]); w.y = cvt_pk_bf16(v0[2], v0[3]); w.z = cvt_pk_bf16(v1[0], v1[1]); w.w = cvt_pk_bf16(v1[2], v1[3]);
                    *(u32x4*)(rowp + bj * 128) = w; } }
    }
};

#define XB_TMO      128
#define XB_XCNT(j)  (256  + 64 * (j))
#define XB_XSUB(j)  (1280 + 64 * (j))
#define XB_XGEN(j)  (2304 + 64 * (j))
#define XB_TOP      3328
#define XB_TOPGEN   3392
#define XCD_BAR_WORDS 3456
#define XB_SPIN_CAP (1u << 18)
__device__ __forceinline__ unsigned xb_ld(unsigned* p)              { return __hip_atomic_load(p, __ATOMIC_RELAXED, __HIP_MEMORY_SCOPE_AGENT); }
__device__ __forceinline__ unsigned xb_add(unsigned* p, unsigned v) { return __hip_atomic_fetch_add(p, v, __ATOMIC_RELAXED, __HIP_MEMORY_SCOPE_AGENT); }
__device__ __forceinline__ unsigned xb_xcc_id() { return (unsigned)__builtin_amdgcn_s_getreg((3 << 11) | 20) & 0xFu; }
#define XB_SPIN(cond, bar) do { unsigned _sp = 0; while (cond) { __builtin_amdgcn_s_sleep(1); \
    if ((++_sp & 255u) == 0u) { if (xb_ld(&(bar)[XB_TMO])) break; if (_sp > XB_SPIN_CAP) { atomicAdd(&(bar)[XB_TMO], 1u); break; } } } } while (0)
struct XcdBarrier { unsigned* bar; unsigned x; volatile LAS unsigned* st; };
__device__ __forceinline__ XcdBarrier xcd_barrier_post(unsigned* bar, volatile LAS unsigned* st) {
    XcdBarrier b; b.bar = bar; b.x = xb_xcc_id(); b.st = st;
    if (threadIdx.x == 0) (void)xb_add(&bar[XB_XCNT(b.x)], 1u);
    return b;
}
__device__ __forceinline__ void xcd_barrier_complete(unsigned* bar, unsigned x, unsigned& nloc, unsigned& nx) {
    const unsigned G = gridDim.x * gridDim.y * gridDim.z;
    unsigned sum, cnt, mine, sp = 0u;
    for (;;) {
        sum = 0u; cnt = 0u; mine = 0u;
#pragma unroll
        for (unsigned j = 0; j < 16; ++j) { const unsigned c = xb_ld(&bar[XB_XCNT(j)]); sum += c; cnt += (c > 0u) ? 1u : 0u; mine = (j == x) ? c : mine; }
        if (sum == G) break;
        __builtin_amdgcn_s_sleep(1);
        if ((++sp & 255u) == 0u) { if (xb_ld(&bar[XB_TMO])) break; if (sp > XB_SPIN_CAP) { atomicAdd(&bar[XB_TMO], 1u); break; } }
    }
    nloc = mine > 0u ? mine : 1u; nx = cnt > 0u ? cnt : 1u;
}
__device__ __forceinline__ void xcd_barrier(const XcdBarrier& b) {
    asm volatile("s_waitcnt vmcnt(0)" ::: "memory");
    __syncthreads();
    if (threadIdx.x == 0) {
        unsigned* bar = b.bar;
        __builtin_amdgcn_s_waitcnt(0);
        unsigned nloc = b.st[0], nx = b.st[1];
        if (nloc == 0u) { xcd_barrier_complete(bar, b.x, nloc, nx); b.st[0] = nloc; b.st[1] = nx; }
        const unsigned old = xb_add(&bar[XB_XSUB(b.x)], 1u);
        const unsigned gen = old / nloc;
        if (old + 1u == (gen + 1u) * nloc) {
            __builtin_amdgcn_fence(__ATOMIC_RELEASE, "agent");
            asm volatile("s_waitcnt vmcnt(0)" ::: "memory");
            const unsigned og = xb_add(&bar[XB_TOP], 1u);
            const unsigned tg = og / nx;
            if (og + 1u == (tg + 1u) * nx) xb_add(&bar[XB_TOPGEN], 1u);
            else XB_SPIN(xb_ld(&bar[XB_TOPGEN]) == tg, bar);
            __builtin_amdgcn_fence(__ATOMIC_ACQUIRE, "agent");
            xb_add(&bar[XB_XGEN(b.x)], 1u);
            asm volatile("s_waitcnt vmcnt(0)" ::: "memory");
        } else {
            XB_SPIN(xb_ld(&bar[XB_XGEN(b.x)]) == gen, bar);
            __builtin_amdgcn_fence(__ATOMIC_ACQUIRE, "agent");
            asm volatile("s_waitcnt vmcnt(0)" ::: "memory");
        }
    }
    __syncthreads();
}

struct Args { const float* in[28]; float* out; unsigned char* ws; int ph_lo, ph_hi; };
struct Frame {
    LAS unsigned char* lds;
    int tid, lane, wave, G, bid;
    const float* const* in; float* out; unsigned char* ws;
};
#define WSP(T, off) ((T*)(F.ws + (off)))

__device__ __forceinline__ int up_map(int n) { const int kind = n >> 10, m = n & 1023; return 256 * (m >> 7) + 8 * ((m & 127) >> 2) + 4 * kind + (m & 3); }
__device__ __forceinline__ void cvt_item(const float* src, int N, bf16* dst, int Kd, int k0, int n0, int mode, LAS float* scr, int lane) {
    f32x4 v[16];
#pragma unroll
    for (int i = 0; i < 16; ++i) { const int k = 4 * i + (lane >> 4); v[i] = *(const f32x4*)(src + (size_t)(k0 + k) * N + n0 + 4 * (lane & 15)); }
#pragma unroll
    for (int i = 0; i < 16; ++i) { const int k = 4 * i + (lane >> 4); LAS float* s = scr + k * 65 + 4 * (lane & 15); s[0] = v[i][0]; s[1] = v[i][1]; s[2] = v[i][2]; s[3] = v[i][3]; }
    LDS_WAIT();
    const int kp = lane & 7;
#pragma unroll
    for (int it = 0; it < 8; ++it) { const int nn = (lane >> 3) + 8 * it; const LAS float* s = scr + (8 * kp) * 65 + nn;
        u32x4 o; o.x = cvt_pk_bf16(s[0], s[65]); o.y = cvt_pk_bf16(s[2 * 65], s[3 * 65]); o.z = cvt_pk_bf16(s[4 * 65], s[5 * 65]); o.w = cvt_pk_bf16(s[6 * 65], s[7 * 65]);
        const int n = n0 + nn; const int dr = mode ? up_map(n) : n;
        *(u32x4*)(dst + (size_t)dr * Kd + k0 + 8 * kp) = o; }
    LDS_WAIT();
}
__device__ __forceinline__ void step_prologue(Frame& F) {
    LAS float* scr = (LAS float*)(F.lds + F.wave * 16640);
    const int gw = F.bid * 8 + F.wave, NGW = F.G * 8;
    constexpr int I0 = DEPTH * 16 * 92, I1 = DEPTH * 256, I2 = DEPTH * 320, I3 = DEPTH * 256, I4 = DEPTH * NE * 512, I5 = DEPTH * NE * 256, I6 = DEPTH * NRB * 4, I7 = I6;
    constexpr int NIT = I0 + I1 + I2 + I3 + I4 + I5 + I6 + I7;
    for (int it = gw; it < NIT; it += NGW) {
        int r = it; const float* src; bf16* dst; int K, N, mode = 0;
        if (r < I0) { src = F.in[6]; dst = WSP(bf16, WS_WIN); K = D; N = PROJ_W; }
        else if ((r -= I0) < I1) { src = F.in[15]; dst = WSP(bf16, WS_WAO); K = D; N = D; }
        else if ((r -= I1) < I2) { src = F.in[16]; dst = WSP(bf16, WS_WRO); K = D_RNN; N = D; }
        else if ((r -= I2) < I3) { src = F.in[17]; dst = WSP(bf16, WS_WO); K = D; N = D; }
        else if ((r -= I3) < I4) { src = F.in[22]; dst = WSP(bf16, WS_WUP); K = D; N = 2 * DFF; mode = 1; }
        else if ((r -= I4) < I5) { src = F.in[24]; dst = WSP(bf16, WS_WDN); K = DFF; N = D; }
        else if ((r -= I5) < I6) { src = F.in[10]; dst = WSP(bf16, WS_WGA); K = RB; N = RB; }
        else { r -= I6; src = F.in[12]; dst = WSP(bf16, WS_WGX); K = RB; N = RB; }
        const int nbn = N / 64, ipb = (K / 64) * nbn, b = r / ipb, rr = r % ipb, kb = rr / nbn, nb = rr % nbn;
        cvt_item(src + (size_t)b * K * N, N, dst + (size_t)b * K * N, K, kb * 64, nb * 64, mode, scr, F.lane);
    }
    float* X = WSP(float, WS_X); bf16* XB = WSP(bf16, WS_XB);
    for (int m = gw; m < NTOK; m += NGW) {
        const float* xs = (m < TP) ? F.in[0] + (size_t)m * D : F.in[1] + (size_t)(m - TP) * D;
#pragma unroll
        for (int j = 0; j < 4; ++j) { const f32x4 v = *(const f32x4*)(xs + 4 * F.lane + 256 * j); *(f32x4*)(X + (size_t)m * D + 4 * F.lane + 256 * j) = v;
            u32x2 w; w.x = cvt_pk_bf16(v[0], v[1]); w.y = cvt_pk_bf16(v[2], v[3]); *(u32x2*)(XB + (size_t)m * D + 4 * F.lane + 256 * j) = w; }
    }
}

constexpr int ATT_K = 0, ATT_V = 32768, ATT_WS = 65536, ATT_OST = 67584;
__device__ __forceinline__ int crow(int r, int hi) { return (r & 3) + 8 * (r >> 2) + 4 * hi; }
__device__ __forceinline__ void attn_prompt_unit(Frame& F, int l, int b, int nb, int kvh) {
    const int tid = F.tid, lane = F.lane, wid = F.wave, r32 = lane & 31, hi = lane >> 5;
    const bf16* PROJ = WSP(bf16, WS_PROJ);
    LAS unsigned char* KL = F.lds + ATT_K; LAS unsigned char* VL = F.lds + ATT_V;
#pragma unroll
    for (int p = 0; p < 4; ++p) {
        const int row = p * 64 + (tid >> 3), ch = tid & 7; const int t = 128 * (nb - 1) + row;
        u32x4 kv = (u32x4){0u, 0u, 0u, 0u}, vv = (u32x4){0u, 0u, 0u, 0u};
        if (t >= 0) { const size_t tok = (size_t)b * SEQ + t; kv = *(const u32x4*)(PROJ + tok * PROJ_W + CK + kvh * 64 + ch * 8); vv = *(const u32x4*)(PROJ + tok * PROJ_W + CV + kvh * 64 + ch * 8); }
        *(LAS u32x4*)(KL + ch * 4096 + row * 16) = kv;
        *(LAS u32x4*)(VL + (ch >> 2) * 16384 + row * 64 + (ch & 3) * 16) = vv;
        if (nb == SEQ / WINDOW - 1 && row >= 128) {
            const size_t o = ((((size_t)l * BATCH + b) * 128 + (row - 128)) * NKV + kvh) * HD + ch * 8;
            float* ok = F.out + O_NKP + o; float* ov = F.out + O_NVP + o;
            *(f32x4*)ok = (f32x4){bflo(kv.x), bfhi(kv.x), bflo(kv.y), bfhi(kv.y)}; *(f32x4*)(ok + 4) = (f32x4){bflo(kv.z), bfhi(kv.z), bflo(kv.w), bfhi(kv.w)};
            *(f32x4*)ov = (f32x4){bflo(vv.x), bfhi(vv.x), bflo(vv.y), bfhi(vv.y)}; *(f32x4*)(ov + 4) = (f32x4){bflo(vv.z), bfhi(vv.z), bflo(vv.w), bfhi(vv.w)};
        }
    }
    __syncthreads();
    const int head = kvh * 8 + wid;
    const float slope2 = exp2f(-0.5f * (float)(head + 1)) * LOG2E;
    const float sink2 = F.in[7][l * NH + head] * LOG2E;
    LAS float* wsf = (LAS float*)(F.lds + ATT_WS) + wid * 64;
    LAS bf16* stg = (LAS bf16*)(F.lds + ATT_OST) + wid * 2048;
    bf16* OATT = WSP(bf16, WS_OATT);
    const LAS unsigned char* kl0 = KL + hi * 4096 + r32 * 16;
    const LAS unsigned char* vl0 = VL + (4 * hi + ((lane & 15) >> 2)) * 64 + ((lane >> 4) & 1) * 32 + (lane & 3) * 8;
#pragma unroll 1
    for (int qs = 0; qs < 4; ++qs) {
        const size_t tok0 = (size_t)b * SEQ + nb * 128 + qs * 32;
        const LAS unsigned char* klq = kl0 + qs * 512; const LAS unsigned char* vlq = vl0 + qs * 2048;
        LAS bf16* stq = stg + (4 * hi) * 64 + r32; const LAS float* wq = wsf + 4 * hi;
        float sl = slope2; int dq = 128 + r32 - 4 * hi;
        asm volatile("" : "+v"(klq), "+v"(vlq), "+v"(stq), "+v"(wq), "+v"(sl), "+v"(dq));
        const float sdq = sl * (float)dq;
        bf16x8 qr[4];
#pragma unroll
        for (int d0 = 0; d0 < 4; ++d0) qr[d0] = *(const bf16x8*)(PROJ + (tok0 + r32) * PROJ_W + head * 64 + d0 * 16 + hi * 8);
        f32x16 p[5];
#pragma unroll
        for (int kb = 0; kb < 5; ++kb) {
            f32x16 a = {};
#pragma unroll
            for (int d0 = 0; d0 < 4; ++d0) { const bf16x8 kf = *(const LAS bf16x8*)(klq + d0 * 8192 + kb * 512); a = __builtin_amdgcn_mfma_f32_32x32x16_bf16(kf, qr[d0], a, 0, 0, 0); }
            p[kb] = a;
            __builtin_amdgcn_sched_barrier(0);
        }
        float mx = -INFINITY;
#pragma unroll
        for (int kb = 0; kb < 5; ++kb) {
            const bool blk_ok = (nb > 0) || (qs + kb >= 4);
#pragma unroll
            for (int r = 0; r < 16; ++r) {
                const int cc = 32 * kb + (r & 3) + 8 * (r >> 2);
                float lg = fmaf(sl, (float)cc, p[kb][r]) - sdq;
                bool ok = blk_ok;
                if (kb == 0) ok = ok && (dq < 128 + cc);
                if (kb == 4) ok = ok && (dq >= cc);
                lg = ok ? lg : -INFINITY;
                p[kb][r] = lg; mx = fmaxf(mx, lg);
            }
        }
        mx = fmaxf(mx, __shfl_xor(mx, 32));
        mx = fmaxf(mx, sink2);
        float sum = 0.f;
#pragma unroll
        for (int kb = 0; kb < 5; ++kb)
#pragma unroll
            for (int r = 0; r < 16; ++r) { const float e = __builtin_amdgcn_exp2f(p[kb][r] - mx); p[kb][r] = e; sum += e; }
        sum += __shfl_xor(sum, 32);
        const float rden = 1.0f / (sum + __builtin_amdgcn_exp2f(sink2 - mx));
        if (hi == 0) wsf[r32] = rden;
        f32x16 o[2]; o[0] = (f32x16){}; o[1] = (f32x16){};
#pragma unroll
        for (int kb = 0; kb < 5; ++kb) {
#pragma unroll
            for (int s = 0; s < 2; ++s) {
                u32x4 pw; pw.x = cvt_pk_bf16(p[kb][8 * s + 0], p[kb][8 * s + 1]); pw.y = cvt_pk_bf16(p[kb][8 * s + 2], p[kb][8 * s + 3]); pw.z = cvt_pk_bf16(p[kb][8 * s + 4], p[kb][8 * s + 5]); pw.w = cvt_pk_bf16(p[kb][8 * s + 6], p[kb][8 * s + 7]);
                const bf16x8 pa = __builtin_bit_cast(bf16x8, pw);
#pragma unroll
                for (int dh = 0; dh < 2; ++dh) {
                    const LAS unsigned char* vp = vlq + dh * 16384 + kb * 2048 + s * 1024;
                    const s16x4 lo = __builtin_amdgcn_ds_read_tr16_b64_v4i16((LAS s16x4*)vp);
                    const s16x4 hh = __builtin_amdgcn_ds_read_tr16_b64_v4i16((LAS s16x4*)(vp + 512));
                    const bf16x8 vf = (bf16x8){lo[0], lo[1], lo[2], lo[3], hh[0], hh[1], hh[2], hh[3]};
                    o[dh] = __builtin_amdgcn_mfma_f32_32x32x16_bf16(pa, vf, o[dh], 0, 0, 0);
                }
                __builtin_amdgcn_sched_barrier(0);
            }
        }
        LDS_WAIT();
#pragma unroll
        for (int r = 0; r < 16; ++r) { const int c0 = (r & 3) + 8 * (r >> 2); const float rl = wq[c0];
            stq[c0 * 64] = (bf16)(cvt_pk_bf16(o[0][r] * rl, 0.f) & 0xffffu); stq[c0 * 64 + 32] = (bf16)(cvt_pk_bf16(o[1][r] * rl, 0.f) & 0xffffu); }
        LDS_WAIT();
#pragma unroll
        for (int i = 0; i < 4; ++i) { const int row = i * 8 + (lane >> 3), ch = lane & 7; const u32x4 v = *(const LAS u32x4*)(stg + row * 64 + ch * 8);
            *(u32x4*)(OATT + (tok0 + row) * D + head * 64 + ch * 8) = v; }
        LDS_WAIT();
    }
    __syncthreads();
}

constexpr int SA_K = 0, SA_V = 33792, SA_Q = 67584, SA_P = 69632;
__device__ __forceinline__ void attn_sample_unit(Frame& F, int l, int b, int kvh) {
    const int tid = F.tid, lane = F.lane, wid = F.wave;
    const bf16* PROJ = WSP(bf16, WS_PROJ);
    LAS float* KS = (LAS float*)(F.lds + SA_K); LAS float* VS = (LAS float*)(F.lds + SA_V);
    const float* ck = F.in[2] + (((size_t)l * DECB + b) * 128) * (NKV * HD) + kvh * HD;
    const float* cv = F.in[3] + (((size_t)l * DECB + b) * 128) * (NKV * HD) + kvh * HD;
    const size_t tokS = (size_t)TP + b;
    float* onk = F.out + O_NKS + (((size_t)l * DECB + b) * 128) * (NKV * HD) + kvh * HD;
    float* onv = F.out + O_NVS + (((size_t)l * DECB + b) * 128) * (NKV * HD) + kvh * HD;
    for (int idx = tid; idx < 129 * 16; idx += 512) {
        const int key = idx >> 4, c4 = (idx & 15) * 4; f32x4 kq, vq;
        if (key < 128) { kq = *(const f32x4*)(ck + (size_t)key * (NKV * HD) + c4); vq = *(const f32x4*)(cv + (size_t)key * (NKV * HD) + c4); }
        else { const u32x2 kw = *(const u32x2*)(PROJ + tokS * PROJ_W + CK + kvh * 64 + c4), vw = *(const u32x2*)(PROJ + tokS * PROJ_W + CV + kvh * 64 + c4);
            kq = (f32x4){bflo(kw.x), bfhi(kw.x), bflo(kw.y), bfhi(kw.y)}; vq = (f32x4){bflo(vw.x), bfhi(vw.x), bflo(vw.y), bfhi(vw.y)}; }
        LAS float* kd = KS + key * 65 + c4; kd[0] = kq[0]; kd[1] = kq[1]; kd[2] = kq[2]; kd[3] = kq[3];
        LAS float* vd = VS + key * 65 + c4; vd[0] = vq[0]; vd[1] = vq[1]; vd[2] = vq[2]; vd[3] = vq[3];
        if (key >= 1) { *(f32x4*)(onk + (size_t)(key - 1) * (NKV * HD) + c4) = kq; *(f32x4*)(onv + (size_t)(key - 1) * (NKV * HD) + c4) = vq; }
    }
    const int head = kvh * 8 + wid;
    LAS float* QS = (LAS float*)(F.lds + SA_Q) + wid * 64; LAS float* PW = (LAS float*)(F.lds + SA_P) + wid * 132;
    QS[lane] = bf2f(PROJ[tokS * PROJ_W + head * 64 + lane]);
    __syncthreads();
    const float slope2 = exp2f(-0.5f * (float)(head + 1)) * LOG2E;
    const float sink2 = F.in[7][l * NH + head] * LOG2E;
    float sc[3]; float mx = -INFINITY;
#pragma unroll
    for (int ps = 0; ps < 3; ++ps) {
        const int key = ps * 64 + lane; float s = 0.f;
        if (key <= 128) { const LAS float* kr = KS + key * 65;
#pragma unroll 16
            for (int d = 0; d < 64; ++d) s += QS[d] * kr[d]; }
        const float dist = (float)(128 - key);
        const bool ok = (key >= 1) && (key <= 128);
        s = ok ? s - slope2 * dist : -INFINITY;
        sc[ps] = s; mx = fmaxf(mx, s);
    }
    mx = fmaxf(wave_max(mx), sink2);
    float sum = 0.f;
#pragma unroll
    for (int ps = 0; ps < 3; ++ps) { sc[ps] = __builtin_amdgcn_exp2f(sc[ps] - mx); sum += sc[ps]; }
    sum = wave_sum(sum);
    const float rden = 1.0f / (sum + __builtin_amdgcn_exp2f(sink2 - mx));
#pragma unroll
    for (int ps = 0; ps < 3; ++ps) { const int key = ps * 64 + lane; if (key <= 128) PW[key] = sc[ps] * rden; }
    LDS_WAIT();
    float o = 0.f;
    for (int key = 1; key <= 128; ++key) o += PW[key] * VS[key * 65 + lane];
    bf16* OATT = WSP(bf16, WS_OATT);
    OATT[tokS * D + head * 64 + lane] = (bf16)(cvt_pk_bf16(o, 0.f) & 0xffffu);
    __syncthreads();
}

constexpr int RNN_A = 0, RNN_XCF = 17408, RNN_H = 34816, RNN_SUM = 52224, RNN_CAR = 54272;
struct RnnConst { float ba[2], bx[2], cl[2]; bf16x8 bfr[2][2][4]; };
__device__ __forceinline__ void rnn_load_const(Frame& F, int l, int n, int half, RnnConst& C) {
    const int lane = F.lane, cbp = F.wave >> 2;
    const bf16* WGA = WSP(bf16, WS_WGA) + ((size_t)l * NRB + n) * RB * RB; const bf16* WGX = WSP(bf16, WS_WGX) + ((size_t)l * NRB + n) * RB * RB;
#pragma unroll
    for (int cb = 0; cb < 2; ++cb) {
        const int oc = 64 * half + 32 * cbp + 16 * cb + (lane & 15); const int gch = 128 * n + oc;
        C.ba[cb] = F.in[11][l * D_RNN + gch]; C.bx[cb] = F.in[13][l * D_RNN + gch];
        const float lam = F.in[14][l * D_RNN + gch];
        C.cl[cb] = -8.0f * log1pf(expf(-lam));
#pragma unroll
        for (int ks = 0; ks < 4; ++ks) { C.bfr[0][cb][ks] = *(const bf16x8*)(WGA + (size_t)oc * RB + 32 * ks + 8 * (lane >> 4)); C.bfr[1][cb][ks] = *(const bf16x8*)(WGX + (size_t)oc * RB + 32 * ks + 8 * (lane >> 4)); }
    }
}
__device__ __forceinline__ void rnn_gates(Frame& F, const RnnConst& C, float (&a)[2][4], float (&bb)[2][4]) {
    const int lane = F.lane, rb = F.wave & 3, cbp = F.wave >> 2;
    f32x4 zr[2], zi[2]; zr[0] = zr[1] = zi[0] = zi[1] = (f32x4){0.f, 0.f, 0.f, 0.f};
#pragma unroll
    for (int ks = 0; ks < 4; ++ks) {
        const bf16x8 af = *(const LAS bf16x8*)(F.lds + RNN_A + (16 * rb + (lane & 15)) * 272 + (32 * ks + 8 * (lane >> 4)) * 2);
#pragma unroll
        for (int cb = 0; cb < 2; ++cb) { zr[cb] = __builtin_amdgcn_mfma_f32_16x16x32_bf16(af, C.bfr[0][cb][ks], zr[cb], 0, 0, 0); zi[cb] = __builtin_amdgcn_mfma_f32_16x16x32_bf16(af, C.bfr[1][cb][ks], zi[cb], 0, 0, 0); }
    }
    const LAS float* XCF = (const LAS float*)(F.lds + RNN_XCF);
#pragma unroll
    for (int cb = 0; cb < 2; ++cb)
#pragma unroll
        for (int r = 0; r < 4; ++r) {
            const int t = 16 * rb + 4 * (lane >> 4) + r, ch = 32 * cbp + 16 * cb + (lane & 15);
            const float rg = fast_sigmoid(zr[cb][r] + C.ba[cb]), ig = fast_sigmoid(zi[cb][r] + C.bx[cb]);
            const float la = C.cl[cb] * rg;
            const float av = __builtin_amdgcn_exp2f(la * LOG2E);
            const float x2 = 2.0f * la;
            float pl = 1.0f + x2 * (1.0f / 7.0f); pl = 1.0f + x2 * (1.0f / 6.0f) * pl; pl = 1.0f + x2 * 0.2f * pl; pl = 1.0f + x2 * 0.25f * pl; pl = 1.0f + x2 * (1.0f / 3.0f) * pl; pl = 1.0f + x2 * 0.5f * pl; pl = -x2 * pl;
            const float em = (x2 > -0.25f) ? pl : (1.0f - av * av);
            a[cb][r] = av; bb[cb][r] = sqrtf(fmaxf(em, 0.f)) * ig * XCF[t * 68 + ch];
        }
}
__device__ __forceinline__ void rnn_prompt_unit(Frame& F, int l, int b, int n, int half) {
    const int tid = F.tid, lane = F.lane, wid = F.wave, rb = wid & 3, cbp = wid >> 2, g4 = lane >> 4;
    const bf16* PROJ = WSP(bf16, WS_PROJ); bf16* YR = WSP(bf16, WS_YRNN);
    RnnConst C; rnn_load_const(F, l, n, half, C);
    float cw[4][2], cbias[2];
#pragma unroll
    for (int e = 0; e < 2; ++e) { cbias[e] = F.in[9][l * D_RNN + 128 * n + 2 * lane + e];
#pragma unroll
        for (int j = 0; j < 4; ++j) cw[j][e] = F.in[8][((size_t)l * 4 + j) * D_RNN + 128 * n + 2 * lane + e]; }
    LAS float* CAR = (LAS float*)(F.lds + RNN_CAR);
    if (tid < 64) CAR[tid] = 0.f;
    const size_t tokb = (size_t)b * SEQ;
    const bf16* xrp = PROJ + CXR + 128 * n + 2 * lane;
    unsigned xw[11], xn[11];
#pragma unroll
    for (int i = 0; i < 11; ++i) { const int t = 8 * wid + i - 3; xw[i] = (t >= 0) ? *(const unsigned*)(xrp + (tokb + t) * PROJ_W) : 0u; }
    for (int c = 0; c < SEQ / 64; ++c) {
        const int t0 = 64 * c;
        if (c + 1 < SEQ / 64) {
#pragma unroll
            for (int i = 0; i < 11; ++i) xn[i] = *(const unsigned*)(xrp + (tokb + t0 + 64 + 8 * wid + i - 3) * PROJ_W);
        }
        const u32x4 gyw = *(const u32x4*)(PROJ + (tokb + t0 + (tid >> 3)) * PROJ_W + CYR + 128 * n + 64 * half + 8 * (tid & 7));
#pragma unroll
        for (int rr = 0; rr < 8; ++rr) {
            float x0 = cbias[0], x1 = cbias[1];
#pragma unroll
            for (int j = 0; j < 4; ++j) { x0 += cw[j][0] * bflo(xw[rr + j]); x1 += cw[j][1] * bfhi(xw[rr + j]); }
            const int row = 8 * wid + rr;
            *(LAS unsigned*)(F.lds + RNN_A + row * 272 + lane * 4) = cvt_pk_bf16(x0, x1);
            if ((lane >> 5) == half) *(LAS f32x2*)(F.lds + RNN_XCF + (row * 68 + 2 * (lane & 31)) * 4) = (f32x2){x0, x1};
        }
        __syncthreads();
        float a[2][4], bb[2][4];
        rnn_gates(F, C, a, bb);
        float Pk[2][4], Hk[2][4], Pex[2], Hex[2];
#pragma unroll
        for (int cb = 0; cb < 2; ++cb) {
            float P = 1.f, H = 0.f;
#pragma unroll
            for (int r = 0; r < 4; ++r) { H = a[cb][r] * H + bb[cb][r]; P = P * a[cb][r]; Pk[cb][r] = P; Hk[cb][r] = H; }
            float Pi = P, Hi = H;
            { const float Pp = __shfl_up(Pi, 16), Hp = __shfl_up(Hi, 16); if (g4 >= 1) { Hi = Pi * Hp + Hi; Pi = Pi * Pp; } }
            { const float Pp = __shfl_up(Pi, 32), Hp = __shfl_up(Hi, 32); if (g4 >= 2) { Hi = Pi * Hp + Hi; Pi = Pi * Pp; } }
            const float Pe = __shfl_up(Pi, 16), He = __shfl_up(Hi, 16);
            Pex[cb] = (g4 >= 1) ? Pe : 1.f; Hex[cb] = (g4 >= 1) ? He : 0.f;
            if (g4 == 3) *(LAS f32x2*)(F.lds + RNN_SUM + (rb * 64 + 32 * cbp + 16 * cb + (lane & 15)) * 8) = (f32x2){Pi, Hi};
        }
        __syncthreads();
#pragma unroll
        for (int cb = 0; cb < 2; ++cb) {
            const int ch = 32 * cbp + 16 * cb + (lane & 15);
            float hc = CAR[(c & 1) * 64 + ch];
#pragma unroll
            for (int q = 0; q < 3; ++q) if (q < rb) { const f32x2 s = *(const LAS f32x2*)(F.lds + RNN_SUM + (q * 64 + ch) * 8); hc = s.x * hc + s.y; }
            const float hs = Pex[cb] * hc + Hex[cb];
            LAS float* HL = (LAS float*)(F.lds + RNN_H);
            float hlast = 0.f;
#pragma unroll
            for (int r = 0; r < 4; ++r) { const float h = Pk[cb][r] * hs + Hk[cb][r]; HL[(16 * rb + 4 * g4 + r) * 68 + ch] = h; hlast = h; }
            if (rb == 3 && g4 == 3) CAR[((c + 1) & 1) * 64 + ch] = hlast;
        }
        __syncthreads();
        {
            const int t = tid >> 3, c8 = 8 * (tid & 7);
            const LAS float* hp = (const LAS float*)(F.lds + RNN_H) + t * 68 + c8;
            const f32x4 h0 = *(const LAS f32x4*)hp, h1 = *(const LAS f32x4*)(hp + 4);
            u32x4 w; w.x = cvt_pk_bf16(h0[0] * bflo(gyw.x), h0[1] * bfhi(gyw.x)); w.y = cvt_pk_bf16(h0[2] * bflo(gyw.y), h0[3] * bfhi(gyw.y));
            w.z = cvt_pk_bf16(h1[0] * bflo(gyw.z), h1[1] * bfhi(gyw.z)); w.w = cvt_pk_bf16(h1[2] * bflo(gyw.w), h1[3] * bfhi(gyw.w));
            *(u32x4*)(YR + (tokb + t0 + t) * D_RNN + 128 * n + 64 * half + c8) = w;
        }
#pragma unroll
        for (int i = 0; i < 11; ++i) xw[i] = xn[i];
    }
    if (tid < 64) F.out[O_NHP + ((size_t)l * BATCH + b) * D_RNN + 128 * n + 64 * half + tid] = CAR[((SEQ / 64) & 1) * 64 + tid];
    if (half == 0 && tid < 384) { const int j = tid >> 7, ch = tid & 127;
        F.out[O_NCP + (((size_t)l * BATCH + b) * 3 + j) * D_RNN + 128 * n + ch] = bf2f(PROJ[(tokb + SEQ - 3 + j) * PROJ_W + CXR + 128 * n + ch]); }
    __syncthreads();
}
__device__ __forceinline__ void rnn_sample_unit(Frame& F, int l, int n, int half, int rc) {
    const int tid = F.tid, lane = F.lane, wid = F.wave, rb = wid & 3, cbp = wid >> 2, g4 = lane >> 4;
    const bf16* PROJ = WSP(bf16, WS_PROJ); bf16* YR = WSP(bf16, WS_YRNN);
    RnnConst C; rnn_load_const(F, l, n, half, C);
    float cw[4][2], cbias[2];
#pragma unroll
    for (int e = 0; e < 2; ++e) { cbias[e] = F.in[9][l * D_RNN + 128 * n + 2 * lane + e];
#pragma unroll
        for (int j = 0; j < 4; ++j) cw[j][e] = F.in[8][((size_t)l * 4 + j) * D_RNN + 128 * n + 2 * lane + e]; }
    const u32x4 gyw = *(const u32x4*)(PROJ + ((size_t)TP + 64 * rc + (tid >> 3)) * PROJ_W + CYR + 128 * n + 64 * half + 8 * (tid & 7));
#pragma unroll
    for (int rr = 0; rr < 8; ++rr) {
        const int row = 8 * wid + rr, bs = 64 * rc + row;
        const float* sc = F.in[4] + (((size_t)l * DECB + bs) * 3) * D_RNN + 128 * n + 2 * lane;
        const f32x2 s0 = *(const f32x2*)sc, s1 = *(const f32x2*)(sc + D_RNN), s2 = *(const f32x2*)(sc + 2 * D_RNN);
        const unsigned xw = *(const unsigned*)(PROJ + ((size_t)TP + bs) * PROJ_W + CXR + 128 * n + 2 * lane);
        const float xa = bflo(xw), xb = bfhi(xw);
        const float x0 = cbias[0] + cw[0][0] * s0.x + cw[1][0] * s1.x + cw[2][0] * s2.x + cw[3][0] * xa;
        const float x1 = cbias[1] + cw[0][1] * s0.y + cw[1][1] * s1.y + cw[2][1] * s2.y + cw[3][1] * xb;
        *(LAS unsigned*)(F.lds + RNN_A + row * 272 + lane * 4) = cvt_pk_bf16(x0, x1);
        if ((lane >> 5) == half) *(LAS f32x2*)(F.lds + RNN_XCF + (row * 68 + 2 * (lane & 31)) * 4) = (f32x2){x0, x1};
        if (half == 0) { float* oc = F.out + O_NCS + (((size_t)l * DECB + bs) * 3) * D_RNN + 128 * n + 2 * lane;
            *(f32x2*)oc = s1; *(f32x2*)(oc + D_RNN) = s2; *(f32x2*)(oc + 2 * D_RNN) = (f32x2){xa, xb}; }
    }
    __syncthreads();
    float a[2][4], bb[2][4];
    rnn_gates(F, C, a, bb);
    LAS float* HL = (LAS float*)(F.lds + RNN_H);
#pragma unroll
    for (int cb = 0; cb < 2; ++cb)
#pragma unroll
        for (int r = 0; r < 4; ++r) {
            const int row = 16 * rb + 4 * g4 + r, ch = 32 * cbp + 16 * cb + (lane & 15), bs = 64 * rc + row, gch = 128 * n + 64 * half + ch;
            const float h0 = F.in[5][((size_t)l * DECB + bs) * D_RNN + gch];
            const float h = a[cb][r] * h0 + bb[cb][r];
            HL[row * 68 + ch] = h;
            F.out[O_NHS + ((size_t)l * DECB + bs) * D_RNN + gch] = h;
        }
    __syncthreads();
    {
        const int t = tid >> 3, c8 = 8 * (tid & 7);
        const LAS float* hp = (const LAS float*)(F.lds + RNN_H) + t * 68 + c8;
        const f32x4 h0 = *(const LAS f32x4*)hp, h1 = *(const LAS f32x4*)(hp + 4);
        u32x4 w; w.x = cvt_pk_bf16(h0[0] * bflo(gyw.x), h0[1] * bfhi(gyw.x)); w.y = cvt_pk_bf16(h0[2] * bflo(gyw.y), h0[3] * bfhi(gyw.y));
        w.z = cvt_pk_bf16(h1[0] * bflo(gyw.z), h1[1] * bfhi(gyw.z)); w.w = cvt_pk_bf16(h1[2] * bflo(gyw.w), h1[3] * bfhi(gyw.w));
        *(u32x4*)(YR + ((size_t)TP + 64 * rc + t) * D_RNN + 128 * n + 64 * half + c8) = w;
    }
    __syncthreads();
}

constexpr int NW_RNN = 160;
__device__ __forceinline__ void step_mix(Frame& F, int l) {
    const int w = F.bid;
    if (F.G >= 2 * NW_RNN - 64 && w < NW_RNN) {
        const int b = w / 20, n = (w % 20) >> 1, half = w & 1;
        rnn_prompt_unit(F, l, b, n, half);
    } else {
        const int base = (F.G >= 2 * NW_RNN - 64) ? NW_RNN : 0, na = F.G - base, wa = w - base;
        if (base == 0) for (int u = wa; u < NW_RNN; u += na) rnn_prompt_unit(F, l, u / 20, (u % 20) >> 1, u & 1);
        for (int u = wa; u < BATCH * 16 * 2; u += na) { const int b = u >> 5, nb = (u >> 1) & 15, kvh = u & 1; attn_prompt_unit(F, l, b, nb, kvh); }
        for (int u = wa; u < DECB * 2; u += na) attn_sample_unit(F, l, u >> 1, u & 1);
        for (int u = wa; u < NRB * 4; u += na) rnn_sample_unit(F, l, u >> 2, (u >> 1) & 1, u & 1);
    }
}

constexpr int RT_WRT = 0, RT_LG = 131072, RT_TK = 132096, RT_HIST = 132352, RT_BASE = 132480, RT_REC = 132608;
constexpr int TOK_PER_WG = 65;
__device__ __forceinline__ void step_ln1_router(Frame& F, int l) {
    const int tid = F.tid, lane = F.lane, wid = F.wave;
    LAS float* WRT = (LAS float*)(F.lds + RT_WRT);
    LAS int* HIST = (LAS int*)(F.lds + RT_HIST); LAS int* BASE = (LAS int*)(F.lds + RT_BASE); LAS int* REC = (LAS int*)(F.lds + RT_REC);
    const float* wr = F.in[20] + (size_t)l * D * NE;
    for (int idx = tid; idx < D * NE / 4; idx += 512) { const int c = idx >> 3, e4 = (idx & 7) * 4; const f32x4 v = *(const f32x4*)(wr + (size_t)c * NE + e4);
        WRT[(e4 + 0) * D + c] = v[0]; WRT[(e4 + 1) * D + c] = v[1]; WRT[(e4 + 2) * D + c] = v[2]; WRT[(e4 + 3) * D + c] = v[3]; }
    if (tid < 32) HIST[tid] = 0;
    __syncthreads();
    const float* X = WSP(float, WS_X); const float* MIX = WSP(float, WS_TMP); float* X1 = WSP(float, WS_X1); bf16* X1B = WSP(bf16, WS_X1B);
    float* GATE = WSP(float, WS_GATE);
    const float* g1 = F.in[18] + l * D; const float* b1 = F.in[19] + l * D; const float* br = F.in[21] + l * NE;
    const int tokbeg = F.bid * TOK_PER_WG, tokend = min(NTOK, tokbeg + TOK_PER_WG);
    LAS float* LG = (LAS float*)(F.lds + RT_LG) + wid * 32; LAS float* TK = (LAS float*)(F.lds + RT_TK) + wid * 8;
    for (int tok = tokbeg + wid; tok < tokend; tok += 8) {
        f32x4 v[4]; float s = 0.f;
#pragma unroll
        for (int j = 0; j < 4; ++j) { const f32x4 xa = *(const f32x4*)(X + (size_t)tok * D + 4 * lane + 256 * j), mm = *(const f32x4*)(MIX + (size_t)tok * D + 4 * lane + 256 * j);
            v[j] = xa * ALPHA + mm; s += (v[j][0] + v[j][1]) + (v[j][2] + v[j][3]); }
        const float mean = wave_sum(s) * (1.0f / D); float s2 = 0.f;
#pragma unroll
        for (int j = 0; j < 4; ++j) { v[j] = v[j] - mean; s2 += (v[j][0] * v[j][0] + v[j][1] * v[j][1]) + (v[j][2] * v[j][2] + v[j][3] * v[j][3]); }
        const float rstd = 1.0f / sqrtf(wave_sum(s2) * (1.0f / D) + LN_EPS);
#pragma unroll
        for (int j = 0; j < 4; ++j) { const f32x4 gg = *(const f32x4*)(g1 + 4 * lane + 256 * j), bb = *(const f32x4*)(b1 + 4 * lane + 256 * j);
            v[j] = v[j] * rstd * gg + bb;
            *(f32x4*)(X1 + (size_t)tok * D + 4 * lane + 256 * j) = v[j];
            u32x2 w; w.x = cvt_pk_bf16(v[j][0], v[j][1]); w.y = cvt_pk_bf16(v[j][2], v[j][3]); *(u32x2*)(X1B + (size_t)tok * D + 4 * lane + 256 * j) = w; }
        float acc[32];
#pragma unroll
        for (int e = 0; e < 32; ++e) { float a = 0.f;
#pragma unroll
            for (int j = 0; j < 4; ++j) { const f32x4 wv = *(const LAS f32x4*)(WRT + e * D + 4 * lane + 256 * j); a += v[j][0] * wv[0] + v[j][1] * wv[1] + v[j][2] * wv[2] + v[j][3] * wv[3]; }
            acc[e] = a; }
#pragma unroll
        for (int st = 0; st < 5; ++st) {
            const int msk = 32 >> st, nkeep = 16 >> st; const bool up = (lane & msk) != 0;
#pragma unroll
            for (int e = 0; e < nkeep; ++e) { const float snd = up ? acc[e] : acc[e + nkeep], kp = up ? acc[e + nkeep] : acc[e]; acc[e] = kp + __shfl_xor(snd, msk); }
        }
        float lg = acc[0] + __shfl_xor(acc[0], 1);
        const int ex = lane >> 1; lg += br[ex];
        if ((lane & 1) == 0) LG[ex] = lg;
        LDS_WAIT();
        int rank = 0;
#pragma unroll
        for (int e = 0; e < 32; ++e) { const float o = LG[e]; rank += (o > lg || (o == lg && e < ex)) ? 1 : 0; }
        if ((lane & 1) == 0 && rank < 4) { TK[rank * 2] = lg; TK[rank * 2 + 1] = __int_as_float(ex); }
        LDS_WAIT();
        const float t0 = TK[0], t1 = TK[2], t2 = TK[4], t3 = TK[6];
        const float e1 = __expf(t1 - t0), e2 = __expf(t2 - t0), e3 = __expf(t3 - t0); const float rs = 1.0f / (1.0f + e1 + e2 + e3);
        if (lane < 4) {
            const float gk = (lane == 0 ? 1.0f : lane == 1 ? e1 : lane == 2 ? e2 : e3) * rs;
            const int ek = __float_as_int(TK[lane * 2 + 1]);
            GATE[(size_t)tok * 4 + lane] = gk;
            const int pos = __hip_atomic_fetch_add(HIST + ek, 1, __ATOMIC_RELAXED, __HIP_MEMORY_SCOPE_WORKGROUP);
            REC[((tok - tokbeg) * 4 + lane) * 2] = ek; REC[((tok - tokbeg) * 4 + lane) * 2 + 1] = pos;
        }
        LDS_WAIT();
    }
    __syncthreads();
    unsigned* CNT = WSP(unsigned, WS_CTL) + CW_CNT + 32 * l;
    if (tid < 32) { const int h = HIST[tid]; BASE[tid] = h ? (int)__hip_atomic_fetch_add(CNT + tid, (unsigned)h, __ATOMIC_RELAXED, __HIP_MEMORY_SCOPE_AGENT) : 0; }
    __syncthreads();
    int* SLOT = WSP(int, WS_SLOT); int* ROWTOK = WSP(int, WS_ROWTOK);
    const int nrec = (tokend - tokbeg) * 4;
    for (int i = tid; i < nrec; i += 512) { const int ek = REC[i * 2], pos = REC[i * 2 + 1]; const int slot = ek * CAP + BASE[ek] + pos; const int tok = tokbeg + (i >> 2);
        SLOT[(size_t)tok * 4 + (i & 3)] = slot; ROWTOK[slot] = tok; }
    __syncthreads();
}

__device__ __forceinline__ void moe_build(Frame& F, int l, int nN, bool gather) {
    LAS int* cnt = (LAS int*)(F.lds + LDS_CTL + 64); LAS int* tbl = (LAS int*)(F.lds + LDS_CTL + 256);
    const unsigned* CNT = WSP(unsigned, WS_CTL) + CW_CNT + 32 * l;
    if (F.tid < 32) cnt[F.tid] = (int)__hip_atomic_load(CNT + F.tid, __ATOMIC_RELAXED, __HIP_MEMORY_SCOPE_AGENT);
    __syncthreads();
    if (F.tid < MAXR) {
        int U = 0;
        for (int e = 0; e < NE; ++e) U += ((cnt[e] + 255) >> 8) * nN;
        const long L = (long)F.tid * F.G + F.bid;
        int pm = -1, pn = 0, ee = 0, nv = 0;
        if (L < U) {
            int wgid = (int)L; { const int q = U / 8, r = U % 8, xcd = wgid % 8, off = wgid / 8; wgid = (xcd < r ? xcd * (q + 1) : r * (q + 1) + (xcd - r) * q) + off; }
            int acc = 0;
            for (int e = 0; e < NE; ++e) { const int nte = (cnt[e] + 255) >> 8, ue = nte * nN;
                if (wgid < acc + ue) { const int j = wgid - acc, pnl = j / nte, tile = j % nte; pm = e * CAPT + tile; pn = e * nN + pnl; ee = e; nv = min(256, cnt[e] - tile * 256); break; }
                acc += ue; }
        }
        tbl[F.tid * 4 + 0] = pm; tbl[F.tid * 4 + 1] = pn; tbl[F.tid * 4 + 2] = ee; tbl[F.tid * 4 + 3] = nv;
    }
    __syncthreads();
    if (gather) {
        const int* ROWTOK = WSP(int, WS_ROWTOK); LAS int* rows = (LAS int*)(F.lds + LDS_ROWS);
        for (int idx = F.tid; idx < MAXR * 256; idx += 512) { const int r = idx >> 8, rl = idx & 255; const int pm = tbl[r * 4], nv = tbl[r * 4 + 3];
            int tok = 0; if (pm >= 0 && rl < nv) tok = ROWTOK[(size_t)pm * 256 + rl]; rows[idx] = tok; }
        __syncthreads();
    }
}

__device__ __forceinline__ void step_ln2(Frame& F, int l) {
    const int lane = F.lane;
    const float* X1 = WSP(float, WS_X1); const bf16* YK = WSP(bf16, WS_YK); const int* SLOT = WSP(int, WS_SLOT); const float* GATE = WSP(float, WS_GATE);
    float* X = WSP(float, WS_X); bf16* XB = WSP(bf16, WS_XB);
    const float* g2 = F.in[26] + l * D; const float* b2 = F.in[27] + l * D;
    const int gw = F.bid * 8 + F.wave, NGW = F.G * 8;
    for (int tok = gw; tok < NTOK; tok += NGW) {
        const int4 sl = *(const int4*)(SLOT + (size_t)tok * 4); const f32x4 gt = *(const f32x4*)(GATE + (size_t)tok * 4);
        const int sls[4] = {sl.x, sl.y, sl.z, sl.w};
        f32x4 v[4]; float s = 0.f;
#pragma unroll
        for (int j = 0; j < 4; ++j) { v[j] = *(const f32x4*)(X1 + (size_t)tok * D + 4 * lane + 256 * j) * ALPHA; }
#pragma unroll
        for (int k = 0; k < 4; ++k)
#pragma unroll
            for (int j = 0; j < 4; ++j) { const u32x2 w = *(const u32x2*)(YK + (size_t)sls[k] * D + 4 * lane + 256 * j); const float gk = gt[k];
                v[j][0] += gk * bflo(w.x); v[j][1] += gk * bfhi(w.x); v[j][2] += gk * bflo(w.y); v[j][3] += gk * bfhi(w.y); }
#pragma unroll
        for (int j = 0; j < 4; ++j) s += (v[j][0] + v[j][1]) + (v[j][2] + v[j][3]);
        const float mean = wave_sum(s) * (1.0f / D); float s2 = 0.f;
#pragma unroll
        for (int j = 0; j < 4; ++j) { v[j] = v[j] - mean; s2 += (v[j][0] * v[j][0] + v[j][1] * v[j][1]) + (v[j][2] * v[j][2] + v[j][3] * v[j][3]); }
        const float rstd = 1.0f / sqrtf(wave_sum(s2) * (1.0f / D) + LN_EPS);
#pragma unroll
        for (int j = 0; j < 4; ++j) { const f32x4 gg = *(const f32x4*)(g2 + 4 * lane + 256 * j), bb = *(const f32x4*)(b2 + 4 * lane + 256 * j);
            v[j] = v[j] * rstd * gg + bb;
            if (l == DEPTH - 1) *(f32x4*)(F.out + O_Y + (size_t)tok * D + 4 * lane + 256 * j) = v[j];
            else { *(f32x4*)(X + (size_t)tok * D + 4 * lane + 256 * j) = v[j];
                u32x2 w; w.x = cvt_pk_bf16(v[j][0], v[j][1]); w.y = cvt_pk_bf16(v[j][2], v[j][3]); *(u32x2*)(XB + (size_t)tok * D + 4 * lane + 256 * j) = w; } }
    }
}

constexpr int STEPS_PER_LAYER = 8, NSTEPS = 1 + DEPTH * STEPS_PER_LAYER;
__global__ void __launch_bounds__(512, 2) fwd_kernel(Args args) {
    extern __shared__ __attribute__((aligned(16))) unsigned char lds_raw[];
    Frame F;
    F.lds = (LAS unsigned char*)lds_raw;
    F.tid = threadIdx.x; F.lane = F.tid & 63; F.wave = __builtin_amdgcn_readfirstlane(F.tid >> 6);
    F.G = gridDim.x; F.bid = blockIdx.x; F.in = args.in; F.out = args.out; F.ws = args.ws;
    for (int u = F.tid; u < (LDS_BYTES - LDS_CTL) / 4; u += 512) ((LAS unsigned*)(F.lds + LDS_CTL))[u] = 0u;
    __syncthreads();
    XcdBarrier bar; bar.bar = WSP(unsigned, WS_CTL) + CW_BAR; bar.x = 0; bar.st = nullptr;
#if MK_SINGLE
    bar = xcd_barrier_post(WSP(unsigned, WS_CTL) + CW_BAR, (volatile LAS unsigned*)(F.lds + LDS_CTL));
#endif
    const int lo = args.ph_lo, hi = args.ph_hi;
#define IN(k) (lo <= (k) && (k) < hi)
#define REFRESH() do { int tz_ = threadIdx.x; asm volatile("" : "+v"(tz_)); F.tid = tz_; F.lane = tz_ & 63; F.wave = __builtin_amdgcn_readfirstlane(tz_ >> 6); int bz_ = blockIdx.x; asm volatile("" : "+s"(bz_)); F.bid = bz_; } while (0)
#if MK_SINGLE
#define SEAM(k) do { if (IN(k) && IN((k) + 1)) xcd_barrier(bar); } while (0)
#else
#define SEAM(k) do { } while (0)
#endif
    if (IN(0)) { step_prologue(F); __syncthreads(); }
    SEAM(0);
    for (int l = 0; l < DEPTH; ++l) {
        const int s0 = 1 + l * STEPS_PER_LAYER;
        if (IN(s0 + 0)) { REFRESH();
            pg8::Gemm g{WSP(bf16, WS_XB), WSP(bf16, WS_WIN) + (size_t)l * PROJ_W * D, D};
            pg8::StaticOrder S; S.init(MPAD, PROJ_W, F.G, F.bid);
            EpiIn E{WSP(bf16, WS_PROJ)};
            pg8::gemm_phase<EpiIn, pg8::StaticOrder, false>(F.lds, g, S, E, nullptr);
        }
        SEAM(s0 + 0);
        if (IN(s0 + 1)) { REFRESH(); step_mix(F, l); }
        SEAM(s0 + 1);
        if (IN(s0 + 2)) { REFRESH();
            { pg8::Gemm g{WSP(bf16, WS_OATT), WSP(bf16, WS_WAO) + (size_t)l * D * D, D};
              pg8::StaticOrder S; S.init(MPAD, D, F.G, F.bid);
              EpiAo E{WSP(float, WS_TMP), WSP(bf16, WS_PROJ)};
              pg8::gemm_phase<EpiAo, pg8::StaticOrder, false>(F.lds, g, S, E, nullptr); }
            { pg8::Gemm g{WSP(bf16, WS_YRNN), WSP(bf16, WS_WRO) + (size_t)l * D * D_RNN, D_RNN};
              pg8::StaticOrder S; S.init(MPAD, D, F.G, F.bid);
              EpiRo E{WSP(float, WS_TMP), WSP(bf16, WS_PROJ), WSP(bf16, WS_MERG)};
              pg8::gemm_phase<EpiRo, pg8::StaticOrder, false>(F.lds, g, S, E, nullptr); }
        }
        SEAM(s0 + 2);
        if (IN(s0 + 3)) { REFRESH();
            pg8::Gemm g{WSP(bf16, WS_MERG), WSP(bf16, WS_WO) + (size_t)l * D * D, D};
            pg8::StaticOrder S; S.init(MPAD, D, F.G, F.bid);
            EpiF32 E{WSP(float, WS_TMP)};
            pg8::gemm_phase<EpiF32, pg8::StaticOrder, false>(F.lds, g, S, E, nullptr);
        }
        SEAM(s0 + 3);
        if (IN(s0 + 4)) { REFRESH(); step_ln1_router(F, l); }
        SEAM(s0 + 4);
        if (IN(s0 + 5)) { REFRESH();
            moe_build(F, l, 8, true);
            pg8::Gemm g{WSP(bf16, WS_X1B), WSP(bf16, WS_WUP) + (size_t)l * NE * 2 * DFF * D, D};
            pg8::MoeOrder S{(const LAS int*)(F.lds + LDS_CTL + 256)};
            EpiUp E{WSP(bf16, WS_ACT), F.in[23] + (size_t)l * NE * 2 * DFF};
            pg8::gemm_phase<EpiUp, pg8::MoeOrder, true>(F.lds, g, S, E, (const LAS int*)(F.lds + LDS_ROWS));
        }
        SEAM(s0 + 5);
        if (IN(s0 + 6)) { REFRESH();
            moe_build(F, l, 4, false);
            pg8::Gemm g{WSP(bf16, WS_ACT), WSP(bf16, WS_WDN) + (size_t)l * NE * D * DFF, DFF};
            pg8::MoeOrder S{(const LAS int*)(F.lds + LDS_CTL + 256)};
            EpiDn E{WSP(bf16, WS_YK), F.in[25] + (size_t)l * NE * D};
            pg8::gemm_phase<EpiDn, pg8::MoeOrder, false>(F.lds, g, S, E, nullptr);
        }
        SEAM(s0 + 6);
        if (IN(s0 + 7)) { REFRESH(); step_ln2(F, l); }
        SEAM(s0 + 7);
    }
#undef IN
#undef SEAM
}

extern "C" void kernel_launch(void* const* d_in, const int* in_sizes, int n_in, void* d_out, int out_size, void* d_ws, size_t ws_size, hipStream_t stream) {
    static int grid = 0;
    if (grid == 0) {
        if (n_in != 28 || ws_size < WS_END) { fprintf(stderr, "kernel_launch: need 28 inputs and >= %zu bytes of workspace; got %d, %zu\n", (size_t)WS_END, n_in, ws_size); grid = -1; return; }
        int dev = 0, cus = 0, per_cu = 0;
        if (hipGetDevice(&dev) != hipSuccess || hipDeviceGetAttribute(&cus, hipDeviceAttributeMultiprocessorCount, dev) != hipSuccess) { grid = -1; return; }
        if (hipFuncSetAttribute((const void*)fwd_kernel, hipFuncAttributeMaxDynamicSharedMemorySize, LDS_BYTES) != hipSuccess) { fprintf(stderr, "kernel_launch: hipFuncSetAttribute failed\n"); grid = -1; return; }
        if (hipOccupancyMaxActiveBlocksPerMultiprocessor(&per_cu, (const void*)fwd_kernel, 512, LDS_BYTES) != hipSuccess || per_cu < 1) { fprintf(stderr, "kernel_launch: occupancy query says %d\n", per_cu); }
        (void)hipGetLastError();
        grid = cus;
    }
    if (grid < 0) return;
    (void)hipMemsetAsync((char*)d_ws + WS_CTL, 0, CTL_BYTES, stream);
    Args a{};
    for (int i = 0; i < 28; ++i) a.in[i] = (const float*)d_in[i];
    a.out = (float*)d_out; a.ws = (unsigned char*)d_ws;
#if MK_SINGLE
    a.ph_lo = 0; a.ph_hi = NSTEPS;
    hipLaunchKernelGGL(fwd_kernel, dim3(grid), dim3(512), LDS_BYTES, stream, a);
#else
    for (int s = 0; s < NSTEPS; ++s) { a.ph_lo = s; a.ph_hi = s + 1; hipLaunchKernelGGL(fwd_kernel, dim3(grid), dim3(512), LDS_BYTES, stream, a); }
#endif
}
```
